# Optimizing an MI355X kernel written in HIP

```python
import math
import jax, jax.numpy as jnp
from jax import lax
import numpy as np

D_MODEL = 1024
BATCH = 8
SEQ = 4096
DEPTH = 4

HEAD_DIM = 64
A_Q_HEADS = 4
A_KV_HEADS = 2
A_RADIUS = 128
B_WIDTH = 256
SHORT_CONV = 3
C_HEADS = 4
C_Q_RANK = 256
C_KV_RANK = 128
C_NOPE_DIM = 64
C_ROPE_DIM = 32
C_V_DIM = 64
C_Q_BLOCK = 128
ROPE_THETA = 10000.0
D_HEADS = 4
D_PATTERNS = ((128, 1), (512, 4), (2048, 16))
REL_BUCKETS = 32
REL_MAX_DISTANCE = 1024
N_BIAS_HEADS = A_Q_HEADS + D_HEADS * len(D_PATTERNS)
MIX_WIDTH = A_Q_HEADS * HEAD_DIM + B_WIDTH + C_HEADS * C_V_DIM + D_HEADS * HEAD_DIM
IN_SPLITS = (A_Q_HEADS * HEAD_DIM, A_KV_HEADS * HEAD_DIM, A_KV_HEADS * HEAD_DIM,
             B_WIDTH, B_WIDTH, B_WIDTH,
             C_Q_RANK, C_KV_RANK, C_ROPE_DIM) + (D_HEADS * HEAD_DIM,) * (3 * len(D_PATTERNS))
IN_WIDTH = sum(IN_SPLITS)
D_FF = ((8 * D_MODEL // 3 + 127) // 128) * 128
FFN_CONV = 3
EPS = 1e-6
NEG = -1e30

kernel_name = 'hybrid_parallel_mixer_encoder'


def rms_norm(x, g):
    x32 = x.astype(jnp.float32)
    y = x32 * lax.rsqrt(jnp.mean(x32 * x32, axis=-1, keepdims=True) + EPS)
    return (y * g.astype(jnp.float32)).astype(x.dtype)


def dwconv3(x, w):
    xp = jnp.pad(x, ((0, 0), (1, 1), (0, 0)))
    return xp[:, :-2] * w[0] + xp[:, 1:-1] * w[1] + xp[:, 2:] * w[2]


def t5_bucket(rel):
    half = REL_BUCKETS // 2
    max_exact = half // 2
    n = jnp.abs(rel)
    n_f = jnp.maximum(n, 1).astype(jnp.float32)
    large = max_exact + (jnp.log(n_f / max_exact) / math.log(REL_MAX_DISTANCE / max_exact)
                         * (half - max_exact)).astype(jnp.int32)
    large = jnp.minimum(large, half - 1)
    return jnp.where(rel > 0, half, 0) + jnp.where(n < max_exact, n, large)


def band_bias(table, radius, stride):
    qi = jnp.arange(radius)[:, None]
    kj = jnp.arange(3 * radius)[None, :]
    rel = (kj - radius - qi) * stride
    return jnp.transpose(table[t5_bucket(rel)], (2, 0, 1))


def banded_attention(q, k, v, bias, sink, return_lse):
    n, L, H, dh = q.shape
    hk = k.shape[2]
    g = H // hk
    R = bias.shape[1]
    nb = -(-L // R)
    Lp = nb * R
    qb = jnp.pad(q, ((0, 0), (0, Lp - L), (0, 0), (0, 0))).reshape(n, nb, R, hk, g, dh)

    def windows(t):
        tp = jnp.pad(t, ((0, 0), (R, Lp - L + R), (0, 0), (0, 0))).reshape(n, nb + 2, R, hk, dh)
        return jnp.concatenate([tp[:, :-2], tp[:, 1:-1], tp[:, 2:]], axis=2)

    kw, vw = windows(k), windows(v)
    s = jnp.einsum('nbqhgd,nbjhd->nbhgqj', qb, kw, preferred_element_type=jnp.float32) * (dh ** -0.5)
    s = s + bias.astype(jnp.float32).reshape(hk, g, R, 3 * R)
    qpos = jnp.arange(Lp).reshape(nb, R, 1)
    kpos = qpos[:, :1] - R + jnp.arange(3 * R)
    valid = (jnp.abs(kpos - qpos) <= R) & (kpos >= 0) & (kpos < L)
    s = jnp.where(valid[None, :, None, None], s, NEG)
    m = jnp.max(s, axis=-1)
    if sink is not None:
        sk = sink.astype(jnp.float32).reshape(1, 1, hk, g, 1)
        m = jnp.maximum(m, sk)
    p = jnp.exp(s - m[..., None])
    den = jnp.sum(p, axis=-1)
    if sink is not None:
        den = den + jnp.exp(sk - m)
    o = jnp.einsum('nbhgqj,nbjhd->nbqhgd', p, vw.astype(jnp.float32)) / jnp.moveaxis(den, -1, 2)[..., None]
    o = o.reshape(n, Lp, H, dh)[:, :L].astype(q.dtype)
    if not return_lse:
        return o
    lse = jnp.moveaxis(m + jnp.log(den), -1, 2).reshape(n, Lp, H)[:, :L]
    return o, lse


def to_strided(t, d):
    b, s, h, dh = t.shape
    return jnp.swapaxes(t.reshape(b, s // d, d, h, dh), 1, 2).reshape(b * d, s // d, h, dh)


def from_strided(t, batch, d):
    L = t.shape[1]
    rest = t.shape[2:]
    return jnp.swapaxes(t.reshape((batch, d, L) + rest), 1, 2).reshape((batch, L * d) + rest)


def rope(t, cos, sin):
    t1, t2 = jnp.split(t, 2, axis=-1)
    cos = cos.astype(t.dtype)
    sin = sin.astype(t.dtype)
    return jnp.concatenate([t1 * cos - t2 * sin, t2 * cos + t1 * sin], axis=-1)


def mla_attention(q_nope, q_rope, k_nope, k_rope, v):
    b, s, h, _ = q_nope.shape
    nq = s // C_Q_BLOCK
    scale = (C_NOPE_DIM + C_ROPE_DIM) ** -0.5

    def block(args):
        qn, qr = args
        sc = (jnp.einsum('bqhd,bkhd->bhqk', qn, k_nope, preferred_element_type=jnp.float32)
              + jnp.einsum('bqhr,bkr->bhqk', qr, k_rope, preferred_element_type=jnp.float32)) * scale
        p = jax.nn.softmax(sc, axis=-1)
        return jnp.einsum('bhqk,bkhd->bqhd', p.astype(v.dtype), v)

    qn_b = jnp.swapaxes(q_nope.reshape(b, nq, C_Q_BLOCK, h, C_NOPE_DIM), 0, 1)
    qr_b = jnp.swapaxes(q_rope.reshape(b, nq, C_Q_BLOCK, h, C_ROPE_DIM), 0, 1)
    o = lax.map(block, (qn_b, qr_b))
    return jnp.swapaxes(o, 0, 1).reshape(b, s, h * C_V_DIM)


def setup_inputs(seed: int = 0) -> dict:
    key = jax.random.key(seed)
    ks = jax.random.split(key, 18)
    f32 = jnp.float32

    def nrm(k, shape, scale):
        return jax.random.normal(k, shape, f32) * scale

    L = DEPTH
    return {
        'x': nrm(ks[0], (BATCH, SEQ, D_MODEL), 1.0),
        'c': nrm(ks[1], (BATCH, D_MODEL), 1.0),
        'positions': jnp.tile(jnp.arange(SEQ, dtype=jnp.int32)[None, :], (BATCH, 1)),
        'rel_bias': nrm(ks[2], (REL_BUCKETS, N_BIAS_HEADS), 0.5),
        'w_mod': nrm(ks[3], (L, D_MODEL, 6 * D_MODEL), 0.5 * D_MODEL ** -0.5),
        'b_mod': nrm(ks[4], (L, 6 * D_MODEL), 0.01),
        'norm_g': 1.0 + nrm(ks[5], (L, 4, D_MODEL), 0.1),
        'w_in': nrm(ks[6], (L, D_MODEL, IN_WIDTH), D_MODEL ** -0.5),
        'a_sink': nrm(ks[7], (L, A_Q_HEADS), 0.5),
        'b_conv': nrm(ks[8], (L, SHORT_CONV, B_WIDTH), SHORT_CONV ** -0.5),
        'c_norm_q': 1.0 + nrm(ks[9], (L, C_Q_RANK), 0.1),
        'c_norm_kv': 1.0 + nrm(ks[10], (L, C_KV_RANK), 0.1),
        'c_w_uq': nrm(ks[11], (L, C_Q_RANK, C_HEADS * (C_NOPE_DIM + C_ROPE_DIM)), C_Q_RANK ** -0.5),
        'c_w_ukv': nrm(ks[12], (L, C_KV_RANK, C_HEADS * (C_NOPE_DIM + C_V_DIM)), C_KV_RANK ** -0.5),
        'w_out': nrm(ks[13], (L, MIX_WIDTH, D_MODEL), MIX_WIDTH ** -0.5),
        'w_up': nrm(ks[14], (L, D_MODEL, 2 * D_FF), D_MODEL ** -0.5),
        'ffn_conv': nrm(ks[15], (L, FFN_CONV, 2 * D_FF), FFN_CONV ** -0.5),
        'w_down': nrm(ks[16], (L, D_FF, D_MODEL), D_FF ** -0.5),
    }


def reference(x, c, positions, rel_bias, w_mod, b_mod, norm_g, w_in, a_sink, b_conv, c_norm_q, c_norm_kv,
              c_w_uq, c_w_ukv, w_out, w_up, ffn_conv, w_down):
    b, s, _ = x.shape
    bias_a = band_bias(rel_bias[:, :A_Q_HEADS], A_RADIUS, 1)
    bias_d = [band_bias(rel_bias[:, A_Q_HEADS + i * D_HEADS:A_Q_HEADS + (i + 1) * D_HEADS], (w // 2) // d, d)
              for i, (w, d) in enumerate(D_PATTERNS)]
    half = C_ROPE_DIM // 2
    inv_freq = ROPE_THETA ** (-jnp.arange(half, dtype=jnp.float32) / half)
    ang = positions.astype(jnp.float32)[..., None] * inv_freq
    cos, sin = jnp.cos(ang), jnp.sin(ang)
    split_idx = [int(i) for i in np.cumsum(IN_SPLITS)[:-1]]
    c_act = jax.nn.silu(c)

    for l in range(DEPTH):
        mod = (c_act @ w_mod[l] + b_mod[l])[:, None, :]
        sh1, sc1, g1, sh2, sc2, g2 = jnp.split(mod, 6, axis=-1)

        h = rms_norm(x, norm_g[l, 0]) * (1 + sc1) + sh1
        parts = jnp.split(h @ w_in[l], split_idx, axis=-1)
        aq, ak, av, bb, bc, bh, cq, ckv, ckr = parts[:9]
        dqkv = parts[9:]

        oa = banded_attention(aq.reshape(b, s, A_Q_HEADS, HEAD_DIM), ak.reshape(b, s, A_KV_HEADS, HEAD_DIM),
                              av.reshape(b, s, A_KV_HEADS, HEAD_DIM), bias_a, a_sink[l], False).reshape(b, s, -1)

        ob = bb * dwconv3(bc * bh, b_conv[l])

        q = (rms_norm(cq, c_norm_q[l]) @ c_w_uq[l]).reshape(b, s, C_HEADS, C_NOPE_DIM + C_ROPE_DIM)
        kv = (rms_norm(ckv, c_norm_kv[l]) @ c_w_ukv[l]).reshape(b, s, C_HEADS, C_NOPE_DIM + C_V_DIM)
        q_rope = rope(q[..., C_NOPE_DIM:], cos[:, :, None, :], sin[:, :, None, :])
        k_rope = rope(ckr, cos, sin)
        oc = mla_attention(q[..., :C_NOPE_DIM], q_rope, kv[..., :C_NOPE_DIM], k_rope, kv[..., C_NOPE_DIM:])

        outs, lses = [], []
        for i, (w, d) in enumerate(D_PATTERNS):
            qd, kd, vd = (to_strided(t.reshape(b, s, D_HEADS, HEAD_DIM), d) for t in dqkv[3 * i:3 * i + 3])
            o, lse = banded_attention(qd, kd, vd, bias_d[i], None, True)
            outs.append(from_strided(o, b, d))
            lses.append(from_strided(lse, b, d))
        wts = jax.nn.softmax(jnp.stack(lses), axis=0)
        od = jnp.sum(jnp.stack(outs).astype(jnp.float32) * wts[..., None], axis=0).astype(x.dtype).reshape(b, s, -1)

        y = jnp.concatenate([oa, ob, oc, od], axis=-1) @ w_out[l]
        x = x + g1 * rms_norm(y, norm_g[l, 1])

        h = rms_norm(x, norm_g[l, 2]) * (1 + sc2) + sh2
        u = dwconv3(h @ w_up[l], ffn_conv[l])
        ug, uv = jnp.split(u, 2, axis=-1)
        y = (jax.nn.gelu(ug, approximate=True) * uv) @ w_down[l]
        x = x + g2 * rms_norm(y, norm_g[l, 3])
    return x
```

```cpp
#include <hip/hip_runtime.h>
#include <hip/hip_cooperative_groups.h>
#include <cstdio>
#include <cstdint>
namespace cg = cooperative_groups;

#define LAS __attribute__((address_space(3)))
typedef unsigned short bf16_t;
typedef short bf16x8 __attribute__((ext_vector_type(8)));
typedef short s16x4 __attribute__((ext_vector_type(4)));
typedef float f32x4 __attribute__((ext_vector_type(4)));
typedef float f32x2 __attribute__((ext_vector_type(2)));
typedef float f32x16 __attribute__((ext_vector_type(16)));
typedef unsigned u32x4 __attribute__((ext_vector_type(4)));
typedef unsigned u32x2 __attribute__((ext_vector_type(2)));
typedef __bf16 bf16x2_t __attribute__((ext_vector_type(2)));

constexpr int NB = 8, SEQ = 4096, T = NB * SEQ, DM = 1024, NIN = 4096, DFF = 2816, DEPTH = 4;
constexpr int NTHREADS = 512, NWAVES = 8;
constexpr float EPS = 1e-6f, LOG2E = 1.4426950408889634f;
constexpr int PRM = 1280;
constexpr size_t HM_OFF = (size_t)T * PRM;
constexpr int UP0 = 1536, UP1 = 1280, ULD = 3072;

constexpr size_t MiB = 1u << 20;
constexpr size_t WS_MOD = 1 * MiB;
constexpr size_t MOD_BYTES = (size_t)DEPTH * NB * 6144 * 4;
constexpr size_t WS_CS = 2 * MiB;
constexpr size_t WS_LUT = 6 * MiB;
constexpr size_t WS_W = 8 * MiB;
constexpr size_t W_IN = WS_W, W_MLA = WS_W + 8 * MiB, W_OUT = WS_W + 9 * MiB, W_UP = WS_W + 11 * MiB, W_DOWN = WS_W + 22 * MiB;
constexpr size_t WS_HB = 36 * MiB;
constexpr size_t WS_PROJ = 100 * MiB;
constexpr size_t WS_ACT = 292 * MiB;
constexpr size_t WS_MIX = 356 * MiB;
constexpr size_t WS_DPART = 420 * MiB;
constexpr size_t WS_KR = 468 * MiB;
constexpr size_t WS_LSE = 470 * MiB;
constexpr size_t WS_END = 472 * MiB;

constexpr int LDS_BYTES = 131072 + 1024 + 8192;
constexpr int LDS_XB = 131072 + 1024;

__device__ __forceinline__ unsigned pk2(float lo, float hi) { f32x2 v = {lo, hi}; bf16x2_t b = __builtin_convertvector(v, bf16x2_t); return __builtin_bit_cast(unsigned, b); }
__device__ __forceinline__ float bf_lo(unsigned w) { return __uint_as_float(w << 16); }
__device__ __forceinline__ float bf_hi(unsigned w) { return __uint_as_float(w & 0xffff0000u); }
__device__ __forceinline__ float bf1(bf16_t w) { return __uint_as_float(((unsigned)w) << 16); }
__device__ __forceinline__ float wave_sum(float v) {
#pragma unroll
    for (int o = 1; o < 64; o <<= 1) v += __shfl_xor(v, o);
    return v;
}
__device__ __forceinline__ float max3f(float a, float b, float c) { float r; asm("v_max3_f32 %0, %1, %2, %3" : "=v"(r) : "v"(a), "v"(b), "v"(c)); return r; }
__device__ __forceinline__ float max2f(float a, float b) { float r; asm("v_max_f32_e32 %0, %1, %2" : "=v"(r) : "v"(a), "v"(b)); return r; }
__device__ __forceinline__ f32x4 unpack4(u32x2 w) { return (f32x4){bf_lo(w.x), bf_hi(w.x), bf_lo(w.y), bf_hi(w.y)}; }
__device__ __forceinline__ u32x2 pack4(f32x4 v) { u32x2 w; w.x = pk2(v[0], v[1]); w.y = pk2(v[2], v[3]); return w; }

__device__ __forceinline__ float gelu_tanh(float x) {
    const float t = x + 0.044715f * x * x * x;
    const float e = __builtin_amdgcn_exp2f(-2.f * 0.7978845608028654f * LOG2E * t);
    return x * __builtin_amdgcn_rcpf(1.f + e);
}
namespace pg8 {
constexpr int BM = 256, BK = 64, HALF = 128, HTB = HALF * BK * 2, STAGE_BYTES = 8 * HTB, NXCD = 8, WGM = 8;
__host__ __device__ __forceinline__ int lds_byte(int r, int c) { const int st = (r >> 4) * 2 + (c >> 5), rr = r & 15, cc = c & 31, ob = rr * 64 + cc * 2; return st * 1024 + (ob ^ (((ob >> 9) & 1) << 5)); }
__host__ __device__ __forceinline__ void stage_rc(int b, int& R, int& C) { const int st = b / 1024, sb = b % 1024, swz = sb ^ (((sb >> 9) & 1) << 5); R = (st >> 1) * 16 + swz / 64; C = (st & 1) * 32 + (swz % 64) / 2; }
__host__ __device__ __forceinline__ int perm32(int rho) { const int n = rho >> 4, i = rho & 15; return 8 * (i >> 2) + 4 * n + (i & 3); }

struct Unit { int pm, pn; };
struct Gemm { const bf16_t* A; const bf16_t* Bt; int M, N, K, lda; };

struct StaticOrder {
    int nM, nN, nwg, G, c;
    __device__ __forceinline__ void init(int M, int N, int G_, int c_) { nM = M / BM; nN = N / BM; nwg = nM * nN; G = G_; c = c_; }
    __device__ __forceinline__ bool next(int i, Unit& u) const {
        const long L = (long)i * G + c; if (L >= nwg) return false;
        int wgid = (int)L; { const int q = nwg / NXCD, r = nwg % NXCD, xcd = wgid % NXCD, off = wgid / NXCD; wgid = (xcd < r ? xcd * (q + 1) : r * (q + 1) + (xcd - r) * q) + off; }
        const int nig = WGM * nN, gid = wgid / nig, fm = gid * WGM, gsz = (nM - fm) < WGM ? (nM - fm) : WGM;
        u.pm = fm + ((wgid % nig) % gsz); u.pn = (wgid % nig) / gsz; return true;
    }
};

struct EpiBf16 {
    static constexpr bool PERM = true, NEEDS_LDS = false;
    bf16_t* O; int ldc;
    __device__ __forceinline__ void operator()(const f32x4 (&acc)[2][2][4][2], const Unit& u, int wr, int wc, int fr, int fq) const {
        const int row0 = u.pm * BM + wr * 64 + fr; const int col0 = u.pn * BM + wc * 32 + 8 * fq;
#pragma unroll
        for (int ai = 0; ai < 2; ++ai)
#pragma unroll
            for (int m = 0; m < 4; ++m) { bf16_t* rowp = O + (size_t)(row0 + ai * HALF + m * 16) * ldc + col0;
#pragma unroll
                for (int bj = 0; bj < 2; ++bj) { const f32x4 v0 = acc[ai][bj][m][0], v1 = acc[ai][bj][m][1];
                    u32x4 w; w.x = pk2(v0[0], v0[1]); w.y = pk2(v0[2], v0[3]); w.z = pk2(v1[0], v1[1]); w.w = pk2(v1[2], v1[3]);
                    *(u32x4*)(rowp + bj * HALF) = w; } }
    }
};
struct EpiProj {
    static constexpr bool PERM = true, NEEDS_LDS = false;
    bf16_t* O;
    __device__ __forceinline__ void operator()(const f32x4 (&acc)[2][2][4][2], const Unit& u, int wr, int wc, int fr, int fq) const {
        const int row0 = u.pm * BM + wr * 64 + fr; const int pn = u.pn;
        const bool rm = (pn >= 2 && pn <= 6);
        const int hm = pn < 2 ? pn : pn - 5;
        const int gsel = pn < 7 ? 0 : (pn - 7) / 3;
        const int dsh = gsel == 0 ? 0 : (gsel == 1 ? 2 : 4);
#pragma unroll
        for (int ai = 0; ai < 2; ++ai)
#pragma unroll
            for (int m = 0; m < 4; ++m) {
                const int row = row0 + ai * HALF + m * 16;
                const int b = row >> 12, s = row & (SEQ - 1);
                const int sp = ((s & ((1 << dsh) - 1)) << (12 - dsh)) + (s >> dsh);
#pragma unroll
                for (int bj = 0; bj < 2; ++bj) { const f32x4 v0 = acc[ai][bj][m][0], v1 = acc[ai][bj][m][1];
                    u32x4 w; w.x = pk2(v0[0], v0[1]); w.y = pk2(v0[2], v0[3]); w.z = pk2(v1[0], v1[1]); w.w = pk2(v1[2], v1[3]);
                    const int c = bj * HALF + wc * 32 + 8 * fq;
                    bf16_t* dst = rm ? O + (size_t)row * PRM + (pn - 2) * 256 + c
                                     : O + HM_OFF + (size_t)hm * T * 256 + ((size_t)(b * 4 + (c >> 6)) * SEQ + sp) * 64 + (c & 63);
                    *(u32x4*)dst = w; }
            }
    }
};
struct EpiMla {
    static constexpr bool PERM = false, NEEDS_LDS = false;
    bf16_t* O; int ldc; const float* cs; float qs;
    __device__ __forceinline__ void operator()(const f32x4 (&acc)[2][2][4][2], const Unit& u, int wr, int wc, int fr, int fq) const {
        const int row0 = u.pm * BM + wr * 64 + fr;
#pragma unroll
        for (int bj = 0; bj < 2; ++bj) {
            const int cgp = u.pn * 8 + bj * 4 + wc;
            const bool rope = (cgp < 12) && ((cgp % 3) == 2);
            const int col0 = cgp * 32 + 4 * fq;
#pragma unroll
            for (int ai = 0; ai < 2; ++ai)
#pragma unroll
                for (int m = 0; m < 4; ++m) {
                    const int row = row0 + ai * HALF + m * 16;
                    f32x4 v0 = acc[ai][bj][m][0], v1 = acc[ai][bj][m][1];
                    if (rope) {
                        const f32x4 c = *(const f32x4*)(cs + (size_t)row * 32 + 4 * fq), s = *(const f32x4*)(cs + (size_t)row * 32 + 16 + 4 * fq);
                        const f32x4 a = v0 * c - v1 * s, b = v1 * c + v0 * s; v0 = a; v1 = b;
                    }
                    if (cgp < 12) { v0 = v0 * qs; v1 = v1 * qs; }
                    const int bq = row >> 12, sq = row & (SEQ - 1);
                    bf16_t* rowp;
                    if (cgp < 12) rowp = O + ((size_t)(bq * 4 + cgp / 3) * SEQ + sq) * 96 + (cgp % 3) * 32 + 4 * fq;
                    else if (cgp < 20) rowp = O + (size_t)T * 384 + ((size_t)(bq * 4 + (cgp - 12) / 2) * SEQ + sq) * 64 + ((cgp - 12) & 1) * 32 + 4 * fq;
                    else rowp = O + (size_t)T * 640 + ((size_t)(bq * 4 + (cgp - 20) / 2) * SEQ + sq) * 64 + ((cgp - 20) & 1) * 32 + 4 * fq;
                    if (cgp < 28) { *(u32x2*)(rowp) = pack4(v0); *(u32x2*)(rowp + 16) = pack4(v1); }
                }
        }
    }
};

#define DPP_ROR1 0x121
#define DPP_ROR15 0x12F
#define DPP_SHR1 0x111
#define DPP_SHL1 0x101
__device__ __forceinline__ float dppf(float old, float src, const int ctrl_sel) {
    int r;
    if (ctrl_sel == 0) r = __builtin_amdgcn_update_dpp(__float_as_int(old), __float_as_int(src), DPP_ROR1, 0xf, 0xf, false);
    else if (ctrl_sel == 1) r = __builtin_amdgcn_update_dpp(__float_as_int(old), __float_as_int(src), DPP_ROR15, 0xf, 0xf, false);
    else if (ctrl_sel == 2) r = __builtin_amdgcn_update_dpp(__float_as_int(old), __float_as_int(src), DPP_SHR1, 0xf, 0xf, false);
    else r = __builtin_amdgcn_update_dpp(__float_as_int(old), __float_as_int(src), DPP_SHL1, 0xf, 0xf, false);
    return __int_as_float(r);
}
struct EpiConv {
    static constexpr bool PERM = true, NEEDS_LDS = true;
    bf16_t* ACTp; float* UH; const float* fw;
    __device__ __forceinline__ void operator()(const f32x4 (&acc)[2][2][4][2], const Unit& u, int wr, int wc, int fr, int fq, LAS unsigned char* lds) const {
        LAS float* XB = (LAS float*)(lds + LDS_XB);
        const int chl = wc * 32 + 8 * fq;
        const int ch = u.pn * 128 + chl;
#pragma unroll
        for (int ai = 0; ai < 2; ++ai) {
            const int blk = 2 * ai + wr;
#pragma unroll
            for (int bj = 0; bj < 2; ++bj)
#pragma unroll
                for (int n = 0; n < 2; ++n) {
                    if (fr == 0) *(LAS f32x4*)(XB + (2 * blk) * 256 + bj * 128 + chl + 4 * n) = acc[ai][bj][0][n];
                    if (fr == 15) *(LAS f32x4*)(XB + (2 * blk + 1) * 256 + bj * 128 + chl + 4 * n) = acc[ai][bj][3][n];
                }
        }
        float wg[3][8], wv[3][8];
#pragma unroll
        for (int t3 = 0; t3 < 3; ++t3) { const f32x4 a0 = *(const f32x4*)(fw + t3 * 5632 + ch), a1 = *(const f32x4*)(fw + t3 * 5632 + ch + 4);
            const f32x4 b0 = *(const f32x4*)(fw + t3 * 5632 + 2816 + ch), b1 = *(const f32x4*)(fw + t3 * 5632 + 2816 + ch + 4);
#pragma unroll
            for (int e = 0; e < 4; ++e) { wg[t3][e] = a0[e]; wg[t3][4 + e] = a1[e]; wv[t3][e] = b0[e]; wv[t3][4 + e] = b1[e]; } }
        asm volatile("s_waitcnt lgkmcnt(0)" ::: "memory"); __builtin_amdgcn_s_barrier(); asm volatile("" ::: "memory");
        {
            float* uh = UH + (size_t)u.pm * 4 * 5632 + u.pn * 256 + chl;
            if (wr == 0 && fr < 2) {
#pragma unroll
                for (int bj = 0; bj < 2; ++bj)
#pragma unroll
                    for (int n = 0; n < 2; ++n) *(f32x4*)(uh + (size_t)fr * 5632 + bj * 128 + 4 * n) = acc[0][bj][0][n];
            }
            if (wr == 1 && fr >= 14) {
#pragma unroll
                for (int bj = 0; bj < 2; ++bj)
#pragma unroll
                    for (int n = 0; n < 2; ++n) *(f32x4*)(uh + (size_t)(fr - 12) * 5632 + bj * 128 + 4 * n) = acc[1][bj][3][n];
            }
        }
#pragma unroll
        for (int ai = 0; ai < 2; ++ai) {
            const int blk = 2 * ai + wr;
#pragma unroll
            for (int m = 0; m < 4; ++m) {
                const int trow = 64 * blk + 16 * m + fr;
                float og[8], ov[8];
#pragma unroll
                for (int bj = 0; bj < 2; ++bj)
#pragma unroll
                    for (int n = 0; n < 2; ++n) {
                        f32x4 pv, nv;
                        if (m == 0) pv = (blk > 0) ? *(const LAS f32x4*)(XB + (2 * blk - 1) * 256 + bj * 128 + chl + 4 * n) : (f32x4){0.f, 0.f, 0.f, 0.f};
                        if (m == 3) nv = (blk < 3) ? *(const LAS f32x4*)(XB + (2 * blk + 2) * 256 + bj * 128 + chl + 4 * n) : (f32x4){0.f, 0.f, 0.f, 0.f};
#pragma unroll
                        for (int e = 0; e < 4; ++e) {
                            const float cur = acc[ai][bj][m][n][e];
                            const float upB = (m == 0) ? pv[e] : dppf(0.f, acc[ai][bj][m == 0 ? 0 : m - 1][n][e], 0);
                            const float dnB = (m == 3) ? nv[e] : dppf(0.f, acc[ai][bj][m == 3 ? 3 : m + 1][n][e], 1);
                            const float up = dppf(upB, cur, 2), dn = dppf(dnB, cur, 3);
                            const int k = 4 * n + e;
                            if (bj == 0) og[k] = wg[0][k] * up + wg[1][k] * cur + wg[2][k] * dn;
                            else         ov[k] = wv[0][k] * up + wv[1][k] * cur + wv[2][k] * dn;
                        }
                    }
                u32x4 ow;
#pragma unroll
                for (int e2 = 0; e2 < 4; ++e2) ow[e2] = pk2(gelu_tanh(og[2 * e2]) * ov[2 * e2], gelu_tanh(og[2 * e2 + 1]) * ov[2 * e2 + 1]);
                if (trow != 0 && trow != 255) *(u32x4*)(ACTp + (size_t)(u.pm * BM + trow) * DFF + ch) = ow;
            }
        }
    }
};

template <class Epi, bool ALIGN_EPI>
__device__ __forceinline__ void gemm_phase(LAS unsigned char* lds, const Gemm g, const StaticOrder& S, const Epi& E) {
    int tid = threadIdx.x; asm volatile("" : "+v"(tid));
    const int wid = __builtin_amdgcn_readfirstlane(tid >> 6), lane = tid & 63, wr = wid >> 2, wc = wid & 3, fr = lane & 15, fq = lane >> 4;
    const int K = g.K, nt = K / BK, lda = g.lda;
    unsigned voffA[2], voffB[2];
#pragma unroll
    for (int i = 0; i < 2; ++i) { int R, C; stage_rc(tid * 16 + i * 8192, R, C); const int Rb = Epi::PERM ? ((R & ~31) + perm32(R & 31)) : R;
        voffA[i] = (unsigned)(R * lda + C) * 2u; voffB[i] = (unsigned)(Rb * K + C) * 2u; }
    const size_t kstep = (size_t)(BK * 2);
    const size_t hstepA = (size_t)HALF * lda * 2, hstepB = (size_t)HALF * K * 2;
    const size_t tstepA = 2 * hstepA, tstepB = 2 * hstepB;
    const unsigned ldsw = (unsigned)wid * 1024u;
    const int aoff = lds_byte(wr * 64 + fr, fq * 8), boff = lds_byte(wc * 32 + fr, fq * 8);
#define PG8_SA(b, h) (((b) * 2 + (h)) * HTB)
#define PG8_SB(b, h) ((4 + (b) * 2 + (h)) * HTB)
#define PG8_STAGE(bufoff, gbase, voff) do { _Pragma("unroll") for (int _i = 0; _i < 2; ++_i) \
        __builtin_amdgcn_global_load_lds((const unsigned*)((const char*)(gbase) + (voff)[_i]), (LAS unsigned*)(lds + (bufoff) + ldsw + _i * 8192), 16, 0, 0); } while (0)
#define PG8_LDA(dst, b, h) do { _Pragma("unroll") for (int m = 0; m < 4; ++m) _Pragma("unroll") for (int k = 0; k < 2; ++k) dst[m][k] = *(const LAS bf16x8*)(lds + PG8_SA(b, h) + aoff + m * 2048 + k * 1024); } while (0)
#define PG8_LDB(dst, b, h) do { _Pragma("unroll") for (int n = 0; n < 2; ++n) _Pragma("unroll") for (int k = 0; k < 2; ++k) dst[n][k] = *(const LAS bf16x8*)(lds + PG8_SB(b, h) + boff + n * 2048 + k * 1024); } while (0)
#define PG8_MMA(ai, bj, At, Bt) do { __builtin_amdgcn_s_setprio(1); _Pragma("unroll") for (int m = 0; m < 4; ++m) _Pragma("unroll") for (int n = 0; n < 2; ++n) _Pragma("unroll") for (int k = 0; k < 2; ++k) \
        acc[ai][bj][m][n] = __builtin_amdgcn_mfma_f32_16x16x32_bf16(Bt[n][k], At[m][k], acc[ai][bj][m][n], 0, 0, 0); __builtin_amdgcn_s_setprio(0); } while (0)
#define PG8_WAIT_V(n) asm volatile("s_waitcnt vmcnt(" #n ")" ::: "memory")
#define PG8_WAIT_L(n) asm volatile("s_waitcnt lgkmcnt(" #n ")" ::: "memory")
#define PG8_BAR __builtin_amdgcn_s_barrier()
#define PG8_SCHED __builtin_amdgcn_sched_barrier(0)
    Unit cur, nxt; int ui = 0;
    if (!S.next(0, cur)) return;
    f32x4 acc[2][2][4][2];
#pragma unroll
    for (int a = 0; a < 2; ++a)
#pragma unroll
        for (int b = 0; b < 2; ++b)
#pragma unroll
            for (int m = 0; m < 4; ++m)
#pragma unroll
                for (int n = 0; n < 2; ++n) acc[a][b][m][n] = (f32x4){0.f, 0.f, 0.f, 0.f};
    bf16x8 At[4][2], B0[2][2], B1[2][2];
    const char* cA = (const char*)g.A + (size_t)cur.pm * tstepA; const char* cB = (const char*)g.Bt + (size_t)cur.pn * tstepB;
    PG8_STAGE(PG8_SB(0, 0), cB, voffB); PG8_STAGE(PG8_SB(0, 1), cB + hstepB, voffB); PG8_STAGE(PG8_SA(0, 0), cA, voffA); PG8_STAGE(PG8_SA(0, 1), cA + hstepA, voffA);
    if (wr == 1) PG8_BAR;
    PG8_WAIT_V(2); PG8_BAR;
    PG8_STAGE(PG8_SB(1, 0), cB + kstep, voffB); PG8_STAGE(PG8_SA(1, 0), cA + kstep, voffA); PG8_STAGE(PG8_SB(1, 1), cB + hstepB + kstep, voffB);
    PG8_WAIT_V(6); PG8_BAR;
    for (;;) {
        const bool has_next = S.next(ui + 1, nxt);
        const char* nA = has_next ? (const char*)g.A + (size_t)nxt.pm * tstepA : cA; const char* nB = has_next ? (const char*)g.Bt + (size_t)nxt.pn * tstepB : cB;
#pragma unroll 1
        for (int t = 0; t < nt; t += 2) {
            const bool last = (t == nt - 2);
            const char* a1 = cA + (size_t)(t + 1) * kstep;
            const char* a2 = last ? nA : cA + (size_t)(t + 2) * kstep; const char* b2 = last ? nB : cB + (size_t)(t + 2) * kstep;
            const char* a3 = a2 + kstep; const char* b3 = b2 + kstep;
            PG8_LDB(B0, 0, 0); PG8_LDB(B1, 0, 1); PG8_SCHED; PG8_LDA(At, 0, 0); PG8_STAGE(PG8_SA(1, 1), a1 + hstepA, voffA);
            PG8_WAIT_V(8); PG8_WAIT_L(0); PG8_BAR; PG8_MMA(0, 0, At, B0); PG8_MMA(0, 1, At, B1); PG8_BAR; PG8_SCHED;
            PG8_LDA(At, 0, 1); PG8_STAGE(PG8_SB(0, 0), b2, voffB); PG8_STAGE(PG8_SB(0, 1), b2 + hstepB, voffB); PG8_STAGE(PG8_SA(0, 0), a2, voffA);
            PG8_WAIT_V(8); PG8_WAIT_L(0); PG8_BAR; PG8_MMA(1, 0, At, B0); PG8_MMA(1, 1, At, B1); PG8_BAR; PG8_SCHED;
            PG8_LDB(B0, 1, 0); PG8_LDB(B1, 1, 1); PG8_SCHED; PG8_LDA(At, 1, 0); PG8_STAGE(PG8_SA(0, 1), a2 + hstepA, voffA);
            PG8_WAIT_V(8); PG8_WAIT_L(0); PG8_BAR; PG8_MMA(0, 0, At, B0); PG8_MMA(0, 1, At, B1); PG8_BAR; PG8_SCHED;
            PG8_LDA(At, 1, 1); PG8_STAGE(PG8_SB(1, 0), b3, voffB); PG8_STAGE(PG8_SB(1, 1), b3 + hstepB, voffB); PG8_STAGE(PG8_SA(1, 0), a3, voffA);
            PG8_WAIT_V(8); PG8_WAIT_L(0); PG8_BAR; PG8_MMA(1, 0, At, B0); PG8_MMA(1, 1, At, B1); PG8_BAR; PG8_SCHED;
        }
        if constexpr (ALIGN_EPI) { if (wr == 0) PG8_BAR; }
        if constexpr (Epi::NEEDS_LDS) E(acc, cur, wr, wc, fr, fq, lds); else E(acc, cur, wr, wc, fr, fq);
        if (!has_next) break;
#pragma unroll
        for (int a = 0; a < 2; ++a)
#pragma unroll
            for (int b = 0; b < 2; ++b)
#pragma unroll
                for (int m = 0; m < 4; ++m)
#pragma unroll
                    for (int n = 0; n < 2; ++n) acc[a][b][m][n] = (f32x4){0.f, 0.f, 0.f, 0.f};
        cur = nxt; cA = nA; cB = nB; ++ui;
        if constexpr (ALIGN_EPI) { if (wr == 1) PG8_BAR; }
    }
    PG8_WAIT_V(0);
    if constexpr (!ALIGN_EPI) { if (wr == 0) PG8_BAR; }
    PG8_BAR;
#undef PG8_SA
#undef PG8_SB
#undef PG8_STAGE
#undef PG8_LDA
#undef PG8_LDB
#undef PG8_MMA
#undef PG8_WAIT_V
#undef PG8_WAIT_L
#undef PG8_BAR
#undef PG8_SCHED
}
}

struct AU {
    const bf16_t* Q; const bf16_t* K1; const bf16_t* K2; const bf16_t* V; bf16_t* O; float* LSE; const float* lut;
    int qpitch, k1pitch, k2pitch, vpitch, opitch, lsepitch;
    int R, q0, kt_lo, kt_hi;
    float sc, m0, l0;
};
constexpr int AT_KBUF = 64 * 208, AT_VBUF = 64 * 192, AT_LUT = 2 * AT_KBUF + 2 * AT_VBUF, AT_PAD = 128;

template <int DK, bool BANDED>
__device__ __forceinline__ void attn_unit(LAS unsigned char* lds, const AU& u, int tid, int wid, int lane) {
    constexpr int KP = DK * 2 + 16, VP = 192, NKS = DK / 16;
    const int r = lane & 31, h = lane >> 5;
    const int qidx = u.q0 + 32 * wid + r;
    LAS float* lut = (LAS float*)(lds + AT_LUT);
    if (BANDED) { for (int i = tid; i < 2 * u.R + 1 + 2 * AT_PAD; i += NTHREADS) { const int j = i - AT_PAD; lut[i] = (j >= 0 && j <= 2 * u.R) ? u.lut[j] : -1e30f; } }
    bf16x8 qf[NKS];
    { const bf16_t* qp = u.Q + (size_t)qidx * u.qpitch + 8 * h;
#pragma unroll
      for (int ks = 0; ks < NKS; ++ks) qf[ks] = *(const bf16x8*)(qp + 16 * ks); }
    float m = u.m0, l = u.l0;
    f32x16 o0, o1;
#pragma unroll
    for (int i = 0; i < 16; ++i) { o0[i] = 0.f; o1[i] = 0.f; }
    const int skey = tid >> 3, sch = tid & 7, skey2 = tid >> 2, sch2 = tid & 3;
    u32x4 kreg, vreg, k2reg = {0u, 0u, 0u, 0u};
#define AT_LOAD(kt_) do { const size_t key_ = (size_t)(64 * (kt_) + skey); \
        kreg = *(const u32x4*)(u.K1 + key_ * u.k1pitch + 8 * sch); vreg = *(const u32x4*)(u.V + key_ * u.vpitch + 8 * sch); \
        if (DK == 96 && tid < 256) k2reg = *(const u32x4*)(u.K2 + (size_t)(64 * (kt_) + skey2) * u.k2pitch + 8 * sch2); } while (0)
    const int qlo = u.q0 + 32 * wid, qhi = qlo + 31;
    AT_LOAD(u.kt_lo);
    for (int kt = u.kt_lo; kt < u.kt_hi; ++kt) {
        const int buf = (kt - u.kt_lo) & 1;
        LAS unsigned char* Kb = lds + buf * AT_KBUF; LAS unsigned char* Vb = lds + 2 * AT_KBUF + buf * AT_VBUF;
        *(LAS u32x4*)(Kb + skey * KP + 16 * sch) = kreg;
        *(LAS u32x4*)(Vb + skey * VP + 16 * sch) = vreg;
        if (DK == 96 && tid < 256) *(LAS u32x4*)(Kb + skey2 * KP + 128 + 16 * sch2) = k2reg;
        __syncthreads();
        if (kt + 1 < u.kt_hi) AT_LOAD(kt + 1);
        const bool active = !BANDED || ((64 * kt + 63 >= qlo - u.R) && (64 * kt <= qhi + u.R));
        if (active) {
            f32x16 p0, p1;
#pragma unroll
            for (int i = 0; i < 16; ++i) { p0[i] = 0.f; p1[i] = 0.f; }
#pragma unroll
            for (int ks = 0; ks < NKS; ++ks) {
                const bf16x8 a0 = *(const LAS bf16x8*)(Kb + r * KP + (16 * ks + 8 * h) * 2);
                const bf16x8 a1 = *(const LAS bf16x8*)(Kb + (32 + r) * KP + (16 * ks + 8 * h) * 2);
                p0 = __builtin_amdgcn_mfma_f32_32x32x16_bf16(a0, qf[ks], p0, 0, 0, 0);
                p1 = __builtin_amdgcn_mfma_f32_32x32x16_bf16(a1, qf[ks], p1, 0, 0, 0);
            }
            __builtin_amdgcn_sched_barrier(0);
            float mx = -1e30f;
            const LAS float* lb = lut + (64 * kt + 4 * h - qidx + u.R + AT_PAD);
#pragma unroll
            for (int i = 0; i < 16; ++i) {
                float s0 = p0[i] * u.sc, s1 = p1[i] * u.sc;
                if (BANDED) { s0 += lb[(i & 3) + 8 * (i >> 2)]; s1 += lb[32 + (i & 3) + 8 * (i >> 2)]; }
                p0[i] = s0; p1[i] = s1; mx = fmaxf(mx, fmaxf(s0, s1));
            }
            mx = fmaxf(mx, __shfl_xor(mx, 32));
            const float mn = fmaxf(m, mx), alpha = __builtin_amdgcn_exp2f(m - mn); m = mn;
            float rs = 0.f;
#pragma unroll
            for (int i = 0; i < 16; ++i) { p0[i] = __builtin_amdgcn_exp2f(p0[i] - mn); p1[i] = __builtin_amdgcn_exp2f(p1[i] - mn); rs += p0[i] + p1[i]; }
            rs += __shfl_xor(rs, 32);
            l = l * alpha + rs;
#pragma unroll
            for (int i = 0; i < 16; ++i) { o0[i] *= alpha; o1[i] *= alpha; }
            __builtin_amdgcn_sched_barrier(0);
            const int trow = 4 * h + ((lane & 15) >> 2), tcol = (16 * ((lane >> 4) & 1) + 4 * (lane & 3)) * 2;
#pragma unroll
            for (int hf = 0; hf < 2; ++hf)
#pragma unroll
                for (int s = 0; s < 2; ++s) {
                    u32x4 xw;
                    if (hf == 0) { xw.x = pk2(p0[8 * s], p0[8 * s + 1]); xw.y = pk2(p0[8 * s + 2], p0[8 * s + 3]); xw.z = pk2(p0[8 * s + 4], p0[8 * s + 5]); xw.w = pk2(p0[8 * s + 6], p0[8 * s + 7]); }
                    else         { xw.x = pk2(p1[8 * s], p1[8 * s + 1]); xw.y = pk2(p1[8 * s + 2], p1[8 * s + 3]); xw.z = pk2(p1[8 * s + 4], p1[8 * s + 5]); xw.w = pk2(p1[8 * s + 6], p1[8 * s + 7]); }
                    const bf16x8 xs = __builtin_bit_cast(bf16x8, xw);
                    const LAS unsigned char* vp = Vb + (32 * hf + 16 * s + trow) * VP + tcol;
                    const s16x4 lo0 = __builtin_bit_cast(s16x4, __builtin_amdgcn_ds_read_tr16_b64_v4i16((LAS s16x4*)(vp)));
                    const s16x4 hi0 = __builtin_bit_cast(s16x4, __builtin_amdgcn_ds_read_tr16_b64_v4i16((LAS s16x4*)(vp + 8 * VP)));
                    const s16x4 lo1 = __builtin_bit_cast(s16x4, __builtin_amdgcn_ds_read_tr16_b64_v4i16((LAS s16x4*)(vp + 64)));
                    const s16x4 hi1 = __builtin_bit_cast(s16x4, __builtin_amdgcn_ds_read_tr16_b64_v4i16((LAS s16x4*)(vp + 8 * VP + 64)));
                    const bf16x8 pa0 = __builtin_shufflevector(lo0, hi0, 0, 1, 2, 3, 4, 5, 6, 7);
                    const bf16x8 pa1 = __builtin_shufflevector(lo1, hi1, 0, 1, 2, 3, 4, 5, 6, 7);
                    o0 = __builtin_amdgcn_mfma_f32_32x32x16_bf16(pa0, xs, o0, 0, 0, 0);
                    o1 = __builtin_amdgcn_mfma_f32_32x32x16_bf16(pa1, xs, o1, 0, 0, 0);
                }
        }
    }
#undef AT_LOAD
    {
        const float inv = 1.f / l;
        bf16_t* op = u.O + (size_t)qidx * u.opitch + 4 * h;
#pragma unroll
        for (int g = 0; g < 4; ++g) {
            u32x2 w0, w1;
            w0.x = pk2(o0[4 * g] * inv, o0[4 * g + 1] * inv); w0.y = pk2(o0[4 * g + 2] * inv, o0[4 * g + 3] * inv);
            w1.x = pk2(o1[4 * g] * inv, o1[4 * g + 1] * inv); w1.y = pk2(o1[4 * g + 2] * inv, o1[4 * g + 3] * inv);
            *(u32x2*)(op + 8 * g) = w0; *(u32x2*)(op + 32 + 8 * g) = w1;
        }
        if (u.LSE && h == 0) u.LSE[(size_t)qidx * u.lsepitch] = m + __builtin_amdgcn_logf(l);
    }
    __syncthreads();
}


constexpr int AC_KP = 208, AC_VP = 192, AC_KBUF = 64 * AC_KP, AC_VBUF = 64 * AC_VP, AC_VOFF = 2 * AC_KBUF;
__device__ __forceinline__ void attn_unit_c(LAS unsigned char* lds, const AU& u, int tid, int wid, int lane) {
    constexpr int NT = SEQ / 64;
    const int r = lane & 31, h = lane >> 5;
    const int qidx = u.q0 + 32 * wid + r;
    bf16x8 qf[6];
    { const bf16_t* qp = u.Q + (size_t)qidx * u.qpitch + 8 * h;
#pragma unroll
      for (int ks = 0; ks < 6; ++ks) qf[ks] = *(const bf16x8*)(qp + 16 * ks); }
    float m = -1e30f, l = 0.f;
    f32x16 o0, o1;
#pragma unroll
    for (int i = 0; i < 16; ++i) { o0[i] = 0.f; o1[i] = 0.f; }
    const int skey = tid >> 3, sch = tid & 7, skey2 = tid >> 2, sch2 = tid & 3;
    u32x4 kreg, vreg, k2reg = {0u, 0u, 0u, 0u};
    const bf16_t* kp1 = u.K1 + (size_t)skey * u.k1pitch + 8 * sch;
    const bf16_t* vp1 = u.V + (size_t)skey * u.vpitch + 8 * sch;
    const bf16_t* kp2 = u.K2 + (size_t)skey2 * u.k2pitch + 8 * sch2;
#define AC_LOAD(kt_) do { kreg = *(const u32x4*)(kp1 + (size_t)(64 * (kt_)) * u.k1pitch); vreg = *(const u32x4*)(vp1 + (size_t)(64 * (kt_)) * u.vpitch); \
        if (tid < 256) k2reg = *(const u32x4*)(kp2 + (size_t)(64 * (kt_)) * u.k2pitch); } while (0)
#define AC_STORE(kt_) do { LAS unsigned char* Kb_ = lds + ((kt_) & 1) * AC_KBUF; LAS unsigned char* Vb_ = lds + AC_VOFF + ((kt_) % 3) * AC_VBUF; \
        *(LAS u32x4*)(Kb_ + skey * AC_KP + 16 * sch) = kreg; *(LAS u32x4*)(Vb_ + skey * AC_VP + 16 * sch) = vreg; \
        if (tid < 256) *(LAS u32x4*)(Kb_ + skey2 * AC_KP + 128 + 16 * sch2) = k2reg; } while (0)
#define AC_QK(P0, P1, kt_) do { const LAS unsigned char* Kb_ = lds + ((kt_) & 1) * AC_KBUF + r * AC_KP + 16 * h; \
        bf16x8 ka_[6], kb_[6]; \
        _Pragma("unroll") for (int ks = 0; ks < 6; ++ks) { ka_[ks] = *(const LAS bf16x8*)(Kb_ + 32 * ks); kb_[ks] = *(const LAS bf16x8*)(Kb_ + 32 * AC_KP + 32 * ks); } \
        _Pragma("unroll") for (int i_ = 0; i_ < 16; ++i_) { P0[i_] = negm; P1[i_] = negm; } \
        _Pragma("unroll") for (int ks = 0; ks < 6; ++ks) { \
            P0 = __builtin_amdgcn_mfma_f32_32x32x16_bf16(ka_[ks], qf[ks], P0, 0, 0, 0); P1 = __builtin_amdgcn_mfma_f32_32x32x16_bf16(kb_[ks], qf[ks], P1, 0, 0, 0); } } while (0)
    const int trow = 4 * h + ((lane & 15) >> 2), tcol = (16 * ((lane >> 4) & 1) + 4 * (lane & 3)) * 2;
#define AC_SOFTMAX_PV(P0, P1, N0, N1, kt_) do { \
          \
        int mq_[4];     \
        _Pragma("unroll") for (int i_ = 0; i_ < 16; ++i_) { P0[i_] = __builtin_amdgcn_exp2f(P0[i_]); P1[i_] = __builtin_amdgcn_exp2f(P1[i_]); \
            if (i_ < 4) mq_[i_] = max(__float_as_int(P0[i_]), __float_as_int(P1[i_])); else mq_[i_ & 3] = max(max(mq_[i_ & 3], __float_as_int(P0[i_])), __float_as_int(P1[i_])); } \
        const LAS unsigned char* Vb_ = lds + AC_VOFF + ((kt_) % 3) * AC_VBUF + trow * AC_VP + tcol; \
        s16x4 vl0_[4], vh0_[4], vl1_[4], vh1_[4]; \
        _Pragma("unroll") for (int q_ = 0; q_ < 4; ++q_) { const LAS unsigned char* vp_ = Vb_ + (16 * q_) * AC_VP; \
            vl0_[q_] = __builtin_bit_cast(s16x4, __builtin_amdgcn_ds_read_tr16_b64_v4i16((LAS s16x4*)(vp_))); \
            vh0_[q_] = __builtin_bit_cast(s16x4, __builtin_amdgcn_ds_read_tr16_b64_v4i16((LAS s16x4*)(vp_ + 8 * AC_VP))); \
            vl1_[q_] = __builtin_bit_cast(s16x4, __builtin_amdgcn_ds_read_tr16_b64_v4i16((LAS s16x4*)(vp_ + 64))); \
            vh1_[q_] = __builtin_bit_cast(s16x4, __builtin_amdgcn_ds_read_tr16_b64_v4i16((LAS s16x4*)(vp_ + 8 * AC_VP + 64))); } \
        f32x16 os_; \
        _Pragma("unroll") for (int i_ = 0; i_ < 16; ++i_) os_[i_] = 0.f; \
        _Pragma("unroll") for (int hf = 0; hf < 2; ++hf) _Pragma("unroll") for (int s = 0; s < 2; ++s) { \
            u32x4 xw_; \
            if (hf == 0) { xw_.x = pk2(P0[8 * s], P0[8 * s + 1]); xw_.y = pk2(P0[8 * s + 2], P0[8 * s + 3]); xw_.z = pk2(P0[8 * s + 4], P0[8 * s + 5]); xw_.w = pk2(P0[8 * s + 6], P0[8 * s + 7]); } \
            else         { xw_.x = pk2(P1[8 * s], P1[8 * s + 1]); xw_.y = pk2(P1[8 * s + 2], P1[8 * s + 3]); xw_.z = pk2(P1[8 * s + 4], P1[8 * s + 5]); xw_.w = pk2(P1[8 * s + 6], P1[8 * s + 7]); } \
            const bf16x8 xs_ = __builtin_bit_cast(bf16x8, xw_); \
            o0 = __builtin_amdgcn_mfma_f32_32x32x16_bf16(__builtin_shufflevector(vl0_[2 * hf + s], vh0_[2 * hf + s], 0, 1, 2, 3, 4, 5, 6, 7), xs_, o0, 0, 0, 0); \
            o1 = __builtin_amdgcn_mfma_f32_32x32x16_bf16(__builtin_shufflevector(vl1_[2 * hf + s], vh1_[2 * hf + s], 0, 1, 2, 3, 4, 5, 6, 7), xs_, o1, 0, 0, 0); \
            os_ = __builtin_amdgcn_mfma_f32_32x32x16_bf16(ones8, xs_, os_, 0, 0, 0); }   \
        asm volatile("s_nop 15\n\ts_nop 7" : "+v"(os_)); \
        l += os_[0]; \
        int emi_ = max(max(max(mq_[0], mq_[1]), mq_[2]), mq_[3]); \
        emi_ = max(emi_, __shfl_xor(emi_, 32)); \
        const float em_ = __int_as_float(emi_); \
        if ((kt_) == 0 || __builtin_amdgcn_ballot_w64(em_ > 256.0f) != 0ull) { \
            const float ec_ = (kt_) == 0 ? fmaxf(em_, 1e-30f) : fmaxf(em_, 1.f); \
            const float dl_ = __builtin_amdgcn_logf(ec_), al_ = __builtin_amdgcn_exp2f(-dl_); l *= al_; \
            _Pragma("unroll") for (int i_ = 0; i_ < 16; ++i_) { o0[i_] *= al_; o1[i_] *= al_; N0[i_] -= dl_; N1[i_] -= dl_; } negm -= dl_; } } while (0)
    f32x16 pA0, pA1, pB0, pB1; float negm = 0.f;
    const bf16x8 ones8 = {16256, 16256, 16256, 16256, 16256, 16256, 16256, 16256};
#pragma unroll
    for (int i = 0; i < 16; ++i) { pB0[i] = 0.f; pB1[i] = 0.f; }
    AC_LOAD(0); AC_STORE(0);
    __syncthreads();
    AC_LOAD(1);
    AC_QK(pA0, pA1, 0);
    for (int t = 0; t < NT; t += 2) {
        AC_STORE(t + 1);
        __syncthreads();
        if (t + 2 < NT) AC_LOAD(t + 2);
        AC_QK(pB0, pB1, t + 1);
        AC_SOFTMAX_PV(pA0, pA1, pB0, pB1, t);
        if (t + 2 < NT) AC_STORE(t + 2);
        __syncthreads();
        if (t + 3 < NT) AC_LOAD(t + 3);
        if (t + 2 < NT) AC_QK(pA0, pA1, t + 2);
        AC_SOFTMAX_PV(pB0, pB1, pA0, pA1, t + 1);
    }
#undef AC_LOAD
#undef AC_STORE
#undef AC_QK
#undef AC_SOFTMAX_PV
    {
        const float inv = 1.f / l;
        bf16_t* op = u.O + (size_t)qidx * u.opitch + 4 * h;
#pragma unroll
        for (int g = 0; g < 4; ++g) {
            u32x2 w0, w1;
            w0.x = pk2(o0[4 * g] * inv, o0[4 * g + 1] * inv); w0.y = pk2(o0[4 * g + 2] * inv, o0[4 * g + 3] * inv);
            w1.x = pk2(o1[4 * g] * inv, o1[4 * g + 1] * inv); w1.y = pk2(o1[4 * g + 2] * inv, o1[4 * g + 3] * inv);
            *(u32x2*)(op + 8 * g) = w0; *(u32x2*)(op + 32 + 8 * g) = w1;
        }
    }
    __syncthreads();
}

constexpr int BW_VP = 192, BW_VBYTES = 64 * BW_VP, BW_LUT = 8 * BW_VBYTES;
__device__ __forceinline__ void attn_unit_w(LAS unsigned char* lds, const AU& u, int tid, int wid, int lane) {
    const int r = lane & 31, h = lane >> 5;
    const int qidx = u.q0 + 32 * wid + r;
    LAS float* lut = (LAS float*)(lds + BW_LUT);
    for (int i = tid; i < 2 * u.R + 1 + 2 * AT_PAD; i += NTHREADS) { const int j = i - AT_PAD; lut[i] = (j >= 0 && j <= 2 * u.R) ? u.lut[j] : -1e30f; }
    bf16x8 qf[4];
    { const bf16_t* qp = u.Q + (size_t)qidx * u.qpitch + 8 * h;
#pragma unroll
      for (int ks = 0; ks < 4; ++ks) qf[ks] = *(const bf16x8*)(qp + 16 * ks); }
    float m = u.m0, l = u.l0;
    f32x16 o0, o1;
#pragma unroll
    for (int i = 0; i < 16; ++i) { o0[i] = 0.f; o1[i] = 0.f; }
    const int qlo = u.q0 + 32 * wid;
    int t_lo = (qlo - u.R) >> 6, t_hi = ((qlo + 31 + u.R) >> 6) + 1;
    t_lo = t_lo < u.kt_lo ? u.kt_lo : t_lo; t_hi = t_hi > u.kt_hi ? u.kt_hi : t_hi;
    LAS unsigned char* Vw = lds + wid * BW_VBYTES;
    const int vkey = lane >> 3, vch = lane & 7;
    bf16x8 kf[8]; u32x4 vr[8];
    const bf16_t* kbase = u.K1 + (size_t)r * u.k1pitch + 8 * h;
    const bf16_t* vbase = u.V + (size_t)vkey * u.vpitch + 8 * vch;
#define BW_LOAD(t_) do { const bf16_t* kp_ = kbase + (size_t)(64 * (t_)) * u.k1pitch; const bf16_t* vp_ = vbase + (size_t)(64 * (t_)) * u.vpitch; \
        _Pragma("unroll") for (int ks = 0; ks < 4; ++ks) { kf[ks] = *(const bf16x8*)(kp_ + 16 * ks); kf[4 + ks] = *(const bf16x8*)(kp_ + (size_t)32 * u.k1pitch + 16 * ks); } \
        _Pragma("unroll") for (int j = 0; j < 8; ++j) vr[j] = *(const u32x4*)(vp_ + (size_t)(8 * j) * u.vpitch); } while (0)
    __syncthreads();
    if (t_lo < t_hi) BW_LOAD(t_lo);
    const int trow = 4 * h + ((lane & 15) >> 2), tcol = (16 * ((lane >> 4) & 1) + 4 * (lane & 3)) * 2;
    for (int kt = t_lo; kt < t_hi; ++kt) {
#pragma unroll
        for (int j = 0; j < 8; ++j) *(LAS u32x4*)(Vw + (vkey + 8 * j) * BW_VP + 16 * vch) = vr[j];
        bf16x8 kc[8];
#pragma unroll
        for (int i = 0; i < 8; ++i) kc[i] = kf[i];
        if (kt + 1 < t_hi) BW_LOAD(kt + 1);
        f32x16 p0, p1;
#pragma unroll
        for (int i = 0; i < 16; ++i) { p0[i] = 0.f; p1[i] = 0.f; }
#pragma unroll
        for (int ks = 0; ks < 4; ++ks) {
            p0 = __builtin_amdgcn_mfma_f32_32x32x16_bf16(kc[ks], qf[ks], p0, 0, 0, 0);
            p1 = __builtin_amdgcn_mfma_f32_32x32x16_bf16(kc[4 + ks], qf[ks], p1, 0, 0, 0);
        }
        const LAS float* lb = lut + (64 * kt + 4 * h - qidx + u.R + AT_PAD);
        float mq[4] = {-1e30f, -1e30f, -1e30f, -1e30f};
#pragma unroll
        for (int i = 0; i < 16; ++i) {
            const float s0 = p0[i] * u.sc + lb[(i & 3) + 8 * (i >> 2)], s1 = p1[i] * u.sc + lb[32 + (i & 3) + 8 * (i >> 2)];
            p0[i] = s0; p1[i] = s1; mq[i & 3] = max3f(mq[i & 3], s0, s1);
        }
        float mx = max2f(max3f(mq[0], mq[1], mq[2]), mq[3]);
        mx = max2f(mx, __shfl_xor(mx, 32));
        const float mn = fmaxf(m, mx), alpha = __builtin_amdgcn_exp2f(m - mn); m = mn;
        float rq[4] = {0.f, 0.f, 0.f, 0.f};
#pragma unroll
        for (int i = 0; i < 16; ++i) { p0[i] = __builtin_amdgcn_exp2f(p0[i] - mn); p1[i] = __builtin_amdgcn_exp2f(p1[i] - mn); rq[i & 3] += p0[i] + p1[i]; }
        float rs = (rq[0] + rq[1]) + (rq[2] + rq[3]);
        rs += __shfl_xor(rs, 32);
        l = l * alpha + rs;
#pragma unroll
        for (int i = 0; i < 16; ++i) { o0[i] *= alpha; o1[i] *= alpha; }
#pragma unroll
        for (int hf = 0; hf < 2; ++hf)
#pragma unroll
            for (int s = 0; s < 2; ++s) {
                u32x4 xw;
                if (hf == 0) { xw.x = pk2(p0[8 * s], p0[8 * s + 1]); xw.y = pk2(p0[8 * s + 2], p0[8 * s + 3]); xw.z = pk2(p0[8 * s + 4], p0[8 * s + 5]); xw.w = pk2(p0[8 * s + 6], p0[8 * s + 7]); }
                else         { xw.x = pk2(p1[8 * s], p1[8 * s + 1]); xw.y = pk2(p1[8 * s + 2], p1[8 * s + 3]); xw.z = pk2(p1[8 * s + 4], p1[8 * s + 5]); xw.w = pk2(p1[8 * s + 6], p1[8 * s + 7]); }
                const bf16x8 xs = __builtin_bit_cast(bf16x8, xw);
                const LAS unsigned char* vp = Vw + (32 * hf + 16 * s + trow) * BW_VP + tcol;
                const s16x4 lo0 = __builtin_bit_cast(s16x4, __builtin_amdgcn_ds_read_tr16_b64_v4i16((LAS s16x4*)(vp)));
                const s16x4 hi0 = __builtin_bit_cast(s16x4, __builtin_amdgcn_ds_read_tr16_b64_v4i16((LAS s16x4*)(vp + 8 * BW_VP)));
                const s16x4 lo1 = __builtin_bit_cast(s16x4, __builtin_amdgcn_ds_read_tr16_b64_v4i16((LAS s16x4*)(vp + 64)));
                const s16x4 hi1 = __builtin_bit_cast(s16x4, __builtin_amdgcn_ds_read_tr16_b64_v4i16((LAS s16x4*)(vp + 8 * BW_VP + 64)));
                o0 = __builtin_amdgcn_mfma_f32_32x32x16_bf16(__builtin_shufflevector(lo0, hi0, 0, 1, 2, 3, 4, 5, 6, 7), xs, o0, 0, 0, 0);
                o1 = __builtin_amdgcn_mfma_f32_32x32x16_bf16(__builtin_shufflevector(lo1, hi1, 0, 1, 2, 3, 4, 5, 6, 7), xs, o1, 0, 0, 0);
            }
    }
#undef BW_LOAD
    {
        int qidx2 = u.q0 + 32 * wid + r; asm volatile("" : "+v"(qidx2));
        const float inv = 1.f / l;
        bf16_t* op = u.O + (size_t)qidx2 * u.opitch + 4 * h;
#pragma unroll
        for (int g = 0; g < 4; ++g) {
            u32x2 w0, w1;
            w0.x = pk2(o0[4 * g] * inv, o0[4 * g + 1] * inv); w0.y = pk2(o0[4 * g + 2] * inv, o0[4 * g + 3] * inv);
            w1.x = pk2(o1[4 * g] * inv, o1[4 * g + 1] * inv); w1.y = pk2(o1[4 * g + 2] * inv, o1[4 * g + 3] * inv);
            *(u32x2*)(op + 8 * g) = w0; *(u32x2*)(op + 32 + 8 * g) = w1;
        }
        if (u.LSE && h == 0) u.LSE[(size_t)qidx2 * u.lsepitch] = m + __builtin_amdgcn_logf(l);
    }
    __syncthreads();
}

struct Args { const void* in[18]; float* out; unsigned char* ws; };

__device__ __forceinline__ void tr_item(const float* W, int ldw, int k0, int n0, bf16_t* D, int ldd, int drow0, int dk0, LAS float* scr, int lane) {
    if (W) {
        float tv_[32];
#pragma unroll
        for (int i = 0; i < 32; ++i) { const int kk = 2 * i + (lane >> 5); tv_[i] = W[(size_t)(k0 + kk) * ldw + n0 + (lane & 31)]; }
#pragma unroll
        for (int i = 0; i < 32; ++i) { const int kk = 2 * i + (lane >> 5); scr[kk * 33 + (lane & 31)] = tv_[i]; }
    }
    asm volatile("s_waitcnt lgkmcnt(0)" ::: "memory");
    const int c = lane & 7;
#pragma unroll
    for (int j = 0; j < 4; ++j) { const int n = (lane >> 3) + 8 * j; const LAS float* s = scr + (8 * c) * 33 + n;
        unsigned z_ = 0u; asm volatile("" : "+v"(z_)); u32x4 o = {z_, z_, z_, z_};
        if (W) { o.x = pk2(s[0 * 33], s[1 * 33]); o.y = pk2(s[2 * 33], s[3 * 33]); o.z = pk2(s[4 * 33], s[5 * 33]); o.w = pk2(s[6 * 33], s[7 * 33]); }
        *(u32x4*)(D + (size_t)(drow0 + n) * ldd + dk0 + 8 * c) = o; }
    asm volatile("s_waitcnt lgkmcnt(0)" ::: "memory");
}

__device__ __forceinline__ void convert_weights(const float* w_in_, const float* w_uq_, const float* w_ukv_, const float* w_out_, const float* w_up_, const float* w_down_, unsigned char* ws_, int l, LAS unsigned char* lds, int gw, int NGW, int wave, int lane) {
    LAS float* scr = (LAS float*)(lds + wave * 16384);
    unsigned char* ws = ws_;
    const float* w_in = w_in_ + (size_t)l * 1024 * 4000;
    const float* w_uq = w_uq_ + (size_t)l * 256 * 384;
    const float* w_ukv = w_ukv_ + (size_t)l * 128 * 512;
    const float* w_out = w_out_ + (size_t)l * 1024 * 1024;
    const float* w_up = w_up_ + (size_t)l * 1024 * 5632;
    const float* w_down = w_down_ + (size_t)l * 2816 * 1024;
    constexpr int I_IN = 16 * 125, I_OUT = 16 * 32, I_UP = 16 * 176, I_DOWN = 44 * 32, I_MLA = 6 * 32;
    constexpr int NIT = I_IN + I_OUT + I_UP + I_DOWN + I_MLA;
    for (int it = gw; it < NIT; it += NGW) {
        int r = it;
        if (r < I_UP) { const int kb = r / 176, nb = r % 176; const int n0 = 32 * nb;
            int drow; { const int c = n0 < 2816 ? n0 : n0 - 2816; drow = 256 * (c >> 7) + (c & 127) + (n0 < 2816 ? 0 : 128); }
            tr_item(w_up, 5632, 64 * kb, n0, (bf16_t*)(ws + W_UP), 1024, drow, 64 * kb, scr, lane); continue; } r -= I_UP;
        if (r < I_IN) { const int kb = r / 125, nb = r % 125; tr_item(w_in, 4000, 64 * kb, 32 * nb, (bf16_t*)(ws + W_IN), 1024, 32 * nb + (32 * nb >= 1696 ? 96 : 0), 64 * kb, scr, lane); continue; } r -= I_IN;
        if (r < I_DOWN) { const int kb = r / 32, nb = r % 32; tr_item(w_down, 1024, 64 * kb, 32 * nb, (bf16_t*)(ws + W_DOWN), 2816, 32 * nb, 64 * kb, scr, lane); continue; } r -= I_DOWN;
        if (r < I_OUT) { const int kb = r / 32, nb = r % 32; tr_item(w_out, 1024, 64 * kb, 32 * nb, (bf16_t*)(ws + W_OUT), 1024, 32 * nb, 64 * kb, scr, lane); continue; } r -= I_OUT;
        { const int kb = r / 32, nb = r % 32, n0 = 32 * nb; const float* W = nullptr; int ldw = 0, k0 = 0, sn0 = 0;
          if (n0 < 384) { if (kb < 4) { W = w_uq; ldw = 384; k0 = 64 * kb; sn0 = n0; } }
          else if (n0 < 896) { if (kb >= 4) { W = w_ukv; ldw = 512; k0 = 64 * (kb - 4);
                  if (n0 < 640) { const int hk = (n0 - 384) / 64, e0 = (n0 - 384) % 64; sn0 = hk * 128 + e0; } else { const int hv = (n0 - 640) / 64, e0 = (n0 - 640) % 64; sn0 = hv * 128 + 64 + e0; } } }
          tr_item(W, ldw, k0, sn0, (bf16_t*)(ws + W_MLA), 384, n0, 64 * kb, scr, lane); }
    }
}

template <int NR, bool XIN16 = false, bool XOUT16 = false>
__device__ __forceinline__ void row_pass(int row, int rstride, const float* xin, const bf16_t* y, const float* gate, const float* gainY, float* xout,
                                         const float* gainH, const float* sc, const float* sh, bf16_t* hout, int lane) {
    f32x4 xv[NR][4]; f32x4 yv[NR][4];
#pragma unroll
    for (int q = 0; q < NR; ++q) {
        if (XIN16) { const u32x2* xr = (const u32x2*)((const bf16_t*)xin + (size_t)(row + q * rstride) * DM) + lane;
#pragma unroll
            for (int j = 0; j < 4; ++j) xv[q][j] = unpack4(xr[64 * j]); }
        else { const f32x4* xr = (const f32x4*)(xin + (size_t)(row + q * rstride) * DM) + lane;
#pragma unroll
            for (int j = 0; j < 4; ++j) xv[q][j] = xr[64 * j]; } }
    if (y) {
#pragma unroll
        for (int q = 0; q < NR; ++q) { const u32x2* yr = (const u32x2*)(y + (size_t)(row + q * rstride) * DM) + lane;
#pragma unroll
            for (int j = 0; j < 4; ++j) yv[q][j] = unpack4(yr[64 * j]); }
        f32x4 g[4], gy[4];
#pragma unroll
        for (int j = 0; j < 4; ++j) { g[j] = ((const f32x4*)gate)[lane + 64 * j]; gy[j] = ((const f32x4*)gainY)[lane + 64 * j]; }
        float ss[NR];
#pragma unroll
        for (int q = 0; q < NR; ++q) { ss[q] = 0.f;
#pragma unroll
            for (int j = 0; j < 4; ++j) ss[q] += (yv[q][j][0] * yv[q][j][0] + yv[q][j][1] * yv[q][j][1]) + (yv[q][j][2] * yv[q][j][2] + yv[q][j][3] * yv[q][j][3]); }
#pragma unroll
        for (int o = 1; o < 64; o <<= 1) {
#pragma unroll
            for (int q = 0; q < NR; ++q) ss[q] += __shfl_xor(ss[q], o); }
#pragma unroll
        for (int q = 0; q < NR; ++q) { const float rstd = rsqrtf(ss[q] * (1.f / DM) + EPS);
            if (XOUT16) { u32x2* xo = (u32x2*)((bf16_t*)xout + (size_t)(row + q * rstride) * DM) + lane;
#pragma unroll
                for (int j = 0; j < 4; ++j) { xv[q][j] = xv[q][j] + g[j] * (yv[q][j] * rstd * gy[j]); xo[64 * j] = pack4(xv[q][j]); xv[q][j] = unpack4(pack4(xv[q][j])); } }
            else { f32x4* xo = (f32x4*)(xout + (size_t)(row + q * rstride) * DM) + lane;
#pragma unroll
                for (int j = 0; j < 4; ++j) { xv[q][j] = xv[q][j] + g[j] * (yv[q][j] * rstd * gy[j]); xo[64 * j] = xv[q][j]; } } }
    }
    if (hout) {
        f32x4 gh[4], s1[4], s0[4];
#pragma unroll
        for (int j = 0; j < 4; ++j) { gh[j] = ((const f32x4*)gainH)[lane + 64 * j]; s1[j] = ((const f32x4*)sc)[lane + 64 * j]; s0[j] = ((const f32x4*)sh)[lane + 64 * j]; }
        float ss[NR];
#pragma unroll
        for (int q = 0; q < NR; ++q) { ss[q] = 0.f;
#pragma unroll
            for (int j = 0; j < 4; ++j) ss[q] += (xv[q][j][0] * xv[q][j][0] + xv[q][j][1] * xv[q][j][1]) + (xv[q][j][2] * xv[q][j][2] + xv[q][j][3] * xv[q][j][3]); }
#pragma unroll
        for (int o = 1; o < 64; o <<= 1) {
#pragma unroll
            for (int q = 0; q < NR; ++q) ss[q] += __shfl_xor(ss[q], o); }
#pragma unroll
        for (int q = 0; q < NR; ++q) { const float rstd = rsqrtf(ss[q] * (1.f / DM) + EPS);
            u32x2* ho = (u32x2*)(hout + (size_t)(row + q * rstride) * DM) + lane;
#pragma unroll
            for (int j = 0; j < 4; ++j) { const f32x4 hv = (xv[q][j] * rstd * gh[j]) * (1.f + s1[j]) + s0[j]; ho[64 * j] = pack4(hv); } }
    }
}

__device__ __forceinline__ int t5_bucket(int rel) {
    const int n = rel < 0 ? -rel : rel;
    int v;
    if (n < 8) v = n; else { int lg = 8 + (int)(__builtin_amdgcn_logf((float)n * 0.125f) * (8.f / 7.f)); v = lg < 15 ? lg : 15; }
    return (rel > 0 ? 16 : 0) + v;
}


#define XB_TMO      128
#define XB_XCNT(j)  (256  + 64 * (j))
#define XB_XSUB(j)  (1280 + 64 * (j))
#define XB_XGEN(j)  (2304 + 64 * (j))
#define XB_TOP      3328
#define XB_TOPGEN   3392
#define XCD_BAR_WORDS 3456
#define XB_SPIN_CAP (1u << 22)
__device__ __forceinline__ unsigned xb_ld(unsigned* p)              { return __hip_atomic_load(p, __ATOMIC_RELAXED, __HIP_MEMORY_SCOPE_AGENT); }
__device__ __forceinline__ unsigned xb_add(unsigned* p, unsigned v) { return __hip_atomic_fetch_add(p, v, __ATOMIC_RELAXED, __HIP_MEMORY_SCOPE_AGENT); }
__device__ __forceinline__ unsigned xb_xcc_id() { return (unsigned)__builtin_amdgcn_s_getreg((3 << 11) | 20) & 0xFu; }
#define XB_SPIN(cond, bar) do { unsigned _sp = 0; while (cond) { __builtin_amdgcn_s_sleep(1); \
    if ((++_sp & 255u) == 0u) { if (xb_ld(&(bar)[XB_TMO])) break; if (_sp > XB_SPIN_CAP) { atomicAdd(&(bar)[XB_TMO], 1u); break; } } } } while (0)
__device__ __forceinline__ void xcd_barrier_complete(unsigned* bar, unsigned x, unsigned& nloc, unsigned& nx) {
    const unsigned G = gridDim.x;
    unsigned sum, cnt, mine, sp = 0u;
    for (;;) {
        sum = 0u; cnt = 0u; mine = 0u;
#pragma unroll
        for (unsigned j = 0; j < 16; ++j) { const unsigned c = xb_ld(&bar[XB_XCNT(j)]); sum += c; cnt += (c > 0u) ? 1u : 0u; mine = (j == x) ? c : mine; }
        if (sum == G) break;
        __builtin_amdgcn_s_sleep(1);
        if ((++sp & 255u) == 0u) { if (xb_ld(&bar[XB_TMO])) break; if (sp > XB_SPIN_CAP) { atomicAdd(&bar[XB_TMO], 1u); break; } }
    }
    nloc = mine > 0u ? mine : 1u; nx = cnt > 0u ? cnt : 1u;
}
__device__ __forceinline__ void xcd_barrier(unsigned* bar, volatile LAS unsigned* st) {
    asm volatile("s_waitcnt vmcnt(0)" ::: "memory");
    __syncthreads();
    if (threadIdx.x == 0) {
        __builtin_amdgcn_s_waitcnt(0);
        const unsigned x = xb_xcc_id();
        unsigned nloc = st[0], nx = st[1];
        if (nloc == 0u) { xcd_barrier_complete(bar, x, nloc, nx); st[0] = nloc; st[1] = nx; }
        const unsigned old = xb_add(&bar[XB_XSUB(x)], 1u);
        const unsigned gen = old / nloc;
        if (old + 1u == (gen + 1u) * nloc) {
            __builtin_amdgcn_fence(__ATOMIC_RELEASE, "agent");
            asm volatile("s_waitcnt vmcnt(0)" ::: "memory");
            const unsigned og = xb_add(&bar[XB_TOP], 1u);
            const unsigned tg = og / nx;
            if (og + 1u == (tg + 1u) * nx) xb_add(&bar[XB_TOPGEN], 1u);
            else XB_SPIN(xb_ld(&bar[XB_TOPGEN]) == tg, bar);
            __builtin_amdgcn_fence(__ATOMIC_ACQUIRE, "agent");
            xb_add(&bar[XB_XGEN(x)], 1u);
            asm volatile("s_waitcnt vmcnt(0)" ::: "memory");
        } else {
            XB_SPIN(xb_ld(&bar[XB_XGEN(x)]) == gen, bar);
            __builtin_amdgcn_fence(__ATOMIC_ACQUIRE, "agent");
            asm volatile("s_waitcnt vmcnt(0)" ::: "memory");
        }
    }
    __syncthreads();
}
typedef const __attribute__((address_space(4))) Args* CArgsP;
__device__ __forceinline__ CArgsP largs() { CArgsP p = (CArgsP)__builtin_amdgcn_kernarg_segment_ptr(); asm volatile("" : "+s"(p)); return p; }
__device__ __forceinline__ int otid() { int t = threadIdx.x; asm volatile("" : "+v"(t)); return t; }
__global__ void __launch_bounds__(NTHREADS) mega(Args a) {
    extern __shared__ __attribute__((aligned(16))) unsigned char lds_raw[];
    LAS unsigned char* lds = (LAS unsigned char*)lds_raw;
    cg::grid_group grid = cg::this_grid();
    volatile LAS unsigned* bst = (volatile LAS unsigned*)(lds + 131072);
    if (threadIdx.x < 2) bst[threadIdx.x] = 0u;
    __syncthreads();
    if (gridDim.x == 0x7fffffffu) grid.sync();
    { CArgsP ap0 = largs(); unsigned* bar0 = (unsigned*)ap0->ws; if (threadIdx.x == 0) (void)xb_add(&bar0[XB_XCNT(xb_xcc_id())], 1u); }
#define GSYNC() do { CArgsP apb_ = largs(); xcd_barrier((unsigned*)apb_->ws, bst); } while (0)
    const int G = gridDim.x, bid = blockIdx.x;
    const int NGW = G * NWAVES, NGT = G * NTHREADS;
#define PHASE_IDS() const int tid = otid(), lane = tid & 63, wave = __builtin_amdgcn_readfirstlane(tid >> 6); const int gw = bid * NWAVES + wave; const int gt = bid * NTHREADS + tid; (void)gw; (void)gt; (void)lane; PTRS()
#define PTRS() CArgsP ap_ = largs(); unsigned char* ws = ap_->ws; const float* x_in = (const float*)ap_->in[0]; const float* c_in = (const float*)ap_->in[1]; const int* positions = (const int*)ap_->in[2]; const float* rel_bias = (const float*)ap_->in[3]; const float* w_mod = (const float*)ap_->in[4]; const float* b_mod = (const float*)ap_->in[5]; const float* norm_g = (const float*)ap_->in[6]; const float* a_sink = (const float*)ap_->in[8]; const float* b_conv = (const float*)ap_->in[9]; const float* c_norm_q = (const float*)ap_->in[10]; const float* c_norm_kv = (const float*)ap_->in[11]; const float* ffn_conv = (const float*)ap_->in[16]; float* MOD = (float*)(ws + WS_MOD); float* CS = (float*)(ws + WS_CS); float* LUTA = (float*)(ws + WS_LUT); float* LUTD = LUTA + 4 * 257; bf16_t* HB = (bf16_t*)(ws + WS_HB); bf16_t* PROJ = (bf16_t*)(ws + WS_PROJ); bf16_t* UB = (bf16_t*)(ws + WS_PROJ); bf16_t* ACT = (bf16_t*)(ws + WS_ACT); bf16_t* MIX = (bf16_t*)(ws + WS_MIX); bf16_t* DPART = (bf16_t*)(ws + WS_DPART); bf16_t* KR = (bf16_t*)(ws + WS_KR); float* LSEB = (float*)(ws + WS_LSE); float* xout = ap_->out; (void)ws; (void)x_in; (void)c_in; (void)positions; (void)rel_bias; (void)w_mod; (void)b_mod; (void)norm_g; (void)a_sink; (void)b_conv; (void)c_norm_q; (void)c_norm_kv; (void)ffn_conv; (void)MOD; (void)CS; (void)LUTA; (void)LUTD; (void)HB; (void)PROJ; (void)UB; (void)ACT; (void)MIX; (void)DPART; (void)KR; (void)LSEB; (void)xout

    { PHASE_IDS();
    LAS float* sl = (LAS float*)(lds + 65536);
    for (int i = tid; i < 8 * 1024; i += NTHREADS) { const float cv = c_in[i]; sl[i] = cv * __builtin_amdgcn_rcpf(1.f + __builtin_amdgcn_exp2f(-cv * LOG2E)); }
    __syncthreads();
    for (int it = gw; it < DEPTH * 24 * 16; it += NGW) {
        const int l = it / 384, rem = it % 384, cb = rem >> 4, kc = rem & 15;
        const int col = cb * 256 + 4 * lane;
        const float* w = w_mod + ((size_t)l * 1024 + kc * 64) * 6144 + col;
        f32x4 acc[8];
#pragma unroll
        for (int b = 0; b < 8; ++b) acc[b] = (f32x4){0.f, 0.f, 0.f, 0.f};
        for (int k0 = 0; k0 < 64; k0 += 8) {
            f32x4 wv[8];
#pragma unroll
            for (int k = 0; k < 8; ++k) wv[k] = *(const f32x4*)(w + (size_t)(k0 + k) * 6144);
#pragma unroll
            for (int k = 0; k < 8; ++k)
#pragma unroll
                for (int b = 0; b < 8; ++b) acc[b] += wv[k] * sl[b * 1024 + kc * 64 + k0 + k];
        }
        float* MP = (float*)(ws + WS_ACT);
#pragma unroll
        for (int b = 0; b < 8; ++b) *(f32x4*)(MP + (((size_t)l * 16 + kc) * 8 + b) * 6144 + col) = acc[b];
    }
    __syncthreads();
    convert_weights((const float*)ap_->in[7], (const float*)ap_->in[12], (const float*)ap_->in[13], (const float*)ap_->in[14], (const float*)ap_->in[15], (const float*)ap_->in[17], ws, 0, lds, gw, NGW, wave, lane);
    for (int i = gt; i < T * 16; i += NGT) {
        const int row = i >> 4, j = i & 15;
        const float invf = __builtin_amdgcn_exp2f(-(float)j * (13.287712379549449f / 16.f));
        const float ang = (float)positions[row] * invf;
        const double rev = (double)ang * 0.15915494309189535;
        const float fr = (float)(rev - __builtin_rint(rev));
        CS[(size_t)row * 32 + j] = __builtin_amdgcn_cosf(fr);
        CS[(size_t)row * 32 + 16 + j] = __builtin_amdgcn_sinf(fr);
    }
    if (bid == 0) {
        for (int i = tid; i < 4 * 257; i += NTHREADS) { const int hd = i / 257, rel = i % 257 - 128; LUTA[i] = rel_bias[t5_bucket(rel) * 16 + hd] * LOG2E; }
        for (int i = tid; i < 12 * 129; i += NTHREADS) { const int gh = i / 129, ri = i % 129 - 64, g = gh >> 2, hd = gh & 3; const int d = (g == 0) ? 1 : (g == 1 ? 4 : 16);
            LUTD[i] = rel_bias[t5_bucket(ri * d) * 16 + 4 + 4 * g + hd] * LOG2E; }
    }
    }
    GSYNC();
    { PHASE_IDS(); const float* MP = (const float*)(ws + WS_ACT);
      for (int i = gt; i < DEPTH * 8 * 6144; i += NGT) { const int l = i / (8 * 6144), rem = i % (8 * 6144), b = rem / 6144, col = rem % 6144;
          float s = b_mod[l * 6144 + col];
#pragma unroll
          for (int kc = 0; kc < 16; ++kc) s += MP[(((size_t)l * 16 + kc) * 8 + b) * 6144 + col];
          MOD[i] = s; } }
    GSYNC();
    { PHASE_IDS();
    for (int row = 2 * gw; row < T; row += 2 * NGW) {
        const int b = row >> 12; const float* md = MOD + (size_t)b * 6144;
        row_pass<2>(row, 1, x_in, nullptr, nullptr, nullptr, nullptr, norm_g, md + 1024, md, HB, lane);
    } }
    GSYNC();

    for (int l = 0; l < DEPTH; ++l) {
        { PTRS(); pg8::Gemm g{HB, (const bf16_t*)(ws + W_IN), T, NIN, 1024, 1024}; pg8::StaticOrder S; S.init(T, NIN, G, bid);
          pg8::EpiProj E{PROJ}; pg8::gemm_phase<pg8::EpiProj, true>(lds, g, S, E); }
        GSYNC();
        { PHASE_IDS();
        const f32x4 gq = ((const f32x4*)(c_norm_q + l * 256))[lane];
        const f32x2 gk = ((const f32x2*)(c_norm_kv + l * 128))[lane];
        const float* bw = b_conv + (size_t)l * 3 * 256;
        const f32x4 w0 = ((const f32x4*)bw)[lane], w1 = ((const f32x4*)(bw + 256))[lane], w2 = ((const f32x4*)(bw + 512))[lane];
        for (int row0 = 4 * gw; row0 < T; row0 += 4 * NGW) {
            bf16_t* pr = PROJ + (size_t)row0 * PRM;
            const int s0 = row0 & (SEQ - 1);
            u32x2 cqw[4]; unsigned ckw[4]; u32x2 bbw[4]; u32x2 bcw[6], bhw[6];
#pragma unroll
            for (int q = 0; q < 4; ++q) { cqw[q] = ((const u32x2*)(pr + (size_t)q * PRM + 768))[lane]; ckw[q] = ((const unsigned*)(pr + (size_t)q * PRM + 1024))[lane];
                bbw[q] = ((const u32x2*)(pr + (size_t)q * PRM + 0))[lane]; }
#pragma unroll
            for (int k = 0; k < 6; ++k) { const bool ok = (k == 0) ? (s0 > 0) : ((k == 5) ? (s0 + 4 < SEQ) : true);
                bcw[k] = (u32x2){0u, 0u}; bhw[k] = bcw[k];
                if (ok) { bcw[k] = ((const u32x2*)(pr + (ptrdiff_t)(k - 1) * PRM + 256))[lane]; bhw[k] = ((const u32x2*)(pr + (ptrdiff_t)(k - 1) * PRM + 512))[lane]; } }
            const int rq = lane >> 4, ri = lane & 15;
            const float t1 = bf1(pr[(size_t)rq * PRM + 1152 + ri]), t2 = bf1(pr[(size_t)rq * PRM + 1168 + ri]);
            const float cs_ = CS[(size_t)(row0 + rq) * 32 + ri], sn = CS[(size_t)(row0 + rq) * 32 + 16 + ri];
            f32x4 cqv[4]; float kv0[4], kv1[4], ssq[4], ssk[4];
#pragma unroll
            for (int q = 0; q < 4; ++q) { cqv[q] = unpack4(cqw[q]); kv0[q] = bf_lo(ckw[q]); kv1[q] = bf_hi(ckw[q]);
                ssq[q] = (cqv[q][0] * cqv[q][0] + cqv[q][1] * cqv[q][1]) + (cqv[q][2] * cqv[q][2] + cqv[q][3] * cqv[q][3]); ssk[q] = kv0[q] * kv0[q] + kv1[q] * kv1[q]; }
#pragma unroll
            for (int o = 1; o < 64; o <<= 1) {
#pragma unroll
                for (int q = 0; q < 4; ++q) { ssq[q] += __shfl_xor(ssq[q], o); ssk[q] += __shfl_xor(ssk[q], o); } }
#pragma unroll
            for (int q = 0; q < 4; ++q) {
                const float rq_ = rsqrtf(ssq[q] * (1.f / 256.f) + EPS), rk_ = rsqrtf(ssk[q] * (1.f / 128.f) + EPS);
                ((u32x2*)(pr + (size_t)q * PRM + 768))[lane] = pack4(cqv[q] * rq_ * gq);
                ((unsigned*)(pr + (size_t)q * PRM + 1024))[lane] = pk2(kv0[q] * rk_ * gk[0], kv1[q] * rk_ * gk[1]);
            }
            KR[(size_t)(row0 + rq) * 32 + ri] = (bf16_t)(pk2(t1 * cs_ - t2 * sn, 0.f) & 0xffffu);
            KR[(size_t)(row0 + rq) * 32 + 16 + ri] = (bf16_t)(pk2(t2 * cs_ + t1 * sn, 0.f) & 0xffffu);
            f32x4 prod[6];
#pragma unroll
            for (int k = 0; k < 6; ++k) prod[k] = unpack4(bcw[k]) * unpack4(bhw[k]);
#pragma unroll
            for (int q = 0; q < 4; ++q) { const f32x4 ob = unpack4(bbw[q]) * (prod[q] * w0 + prod[q + 1] * w1 + prod[q + 2] * w2);
                ((u32x2*)(MIX + (size_t)(row0 + q) * 1024 + 256))[lane] = pack4(ob); }
        } }
        GSYNC();
        { PTRS(); pg8::Gemm g{PROJ + 768, (const bf16_t*)(ws + W_MLA), T, 1024, 384, PRM}; pg8::StaticOrder S; S.init(T, 1024, G, bid);
          pg8::EpiMla E{HB, 1024, CS, 0.10206207261596575f * LOG2E}; pg8::gemm_phase<pg8::EpiMla, true>(lds, g, S, E); }
        GSYNC();
        { PHASE_IDS();
        if (wave >= 4) __builtin_amdgcn_s_setprio(1);
        for (int ui = bid; ui < 5 * 512; ui += G) {
            const int kind = ui >> 9, idx = ui & 511;
            const int bb = idx >> 6, rem = idx & 63, head = rem >> 4, rr = rem & 15;
            AU u;
            if (kind == 0) {
                const size_t hrow = (size_t)(bb * 4 + head) * SEQ;
                u.Q = HB + hrow * 96; u.qpitch = 96; u.K1 = HB + (size_t)T * 384 + hrow * 64; u.k1pitch = 64; u.K2 = KR + (size_t)bb * SEQ * 32; u.k2pitch = 32;
                u.V = HB + (size_t)T * 640 + hrow * 64; u.vpitch = 64; u.O = MIX + (size_t)bb * SEQ * 1024 + 512 + head * 64; u.opitch = 1024; u.LSE = nullptr; u.lsepitch = 0; u.lut = nullptr;
                u.R = 1 << 20; u.q0 = 256 * rr; u.kt_lo = 0; u.kt_hi = 64; u.sc = 0.10206207261596575f * LOG2E; u.m0 = -1e30f; u.l0 = 0.f;
                attn_unit_c(lds, u, tid, wave, lane);
            } else {
                int Ls;
                if (kind == 1) {
                    const bf16_t* hmb = PROJ + HM_OFF;
                    u.Q = hmb + ((size_t)(bb * 4 + head) * SEQ) * 64; u.qpitch = 64;
                    u.K1 = hmb + (size_t)T * 256 + ((size_t)(bb * 4 + (head >> 1)) * SEQ) * 64; u.k1pitch = 64;
                    u.V = hmb + (size_t)T * 256 + ((size_t)(bb * 4 + 2 + (head >> 1)) * SEQ) * 64; u.vpitch = 64;
                    u.O = MIX + (size_t)bb * SEQ * 1024 + head * 64; u.opitch = 1024; u.LSE = nullptr; u.lsepitch = 0; u.lut = LUTA + head * 257;
                    u.R = 128; u.q0 = 256 * rr; Ls = SEQ; u.m0 = a_sink[l * 4 + head] * LOG2E; u.l0 = 1.f;
                } else {
                    const int g = kind - 2, d = (g == 0) ? 1 : (g == 1 ? 4 : 16);
                    const int res = rr % d, qb = rr / d; Ls = SEQ / d;
                    const size_t brow = (size_t)bb * SEQ + res;
                    { const bf16_t* hmb = PROJ + HM_OFF; const size_t hoff = ((size_t)(bb * 4 + head) * SEQ + (size_t)res * Ls) * 64;
                      u.Q = hmb + (size_t)(2 + 3 * g) * T * 256 + hoff; u.K1 = hmb + (size_t)(3 + 3 * g) * T * 256 + hoff; u.V = hmb + (size_t)(4 + 3 * g) * T * 256 + hoff;
                      u.qpitch = 64; u.k1pitch = 64; u.vpitch = 64; }
                    u.O = DPART + (size_t)g * T * 256 + brow * 256 + head * 64; u.opitch = d * 256; u.LSE = LSEB + (size_t)g * T * 4 + brow * 4 + head; u.lsepitch = 4 * d;
                    u.lut = LUTD + (g * 4 + head) * 129; u.R = 64; u.q0 = 256 * qb; u.m0 = -1e30f; u.l0 = 0.f;
                }
                u.K2 = nullptr; u.k2pitch = 0; u.sc = 0.125f * LOG2E;
                const int lo = (u.q0 - u.R) >> 6, hi = ((u.q0 + 255 + u.R) >> 6) + 1;
                u.kt_lo = lo < 0 ? 0 : lo; u.kt_hi = hi > (Ls >> 6) ? (Ls >> 6) : hi;
                attn_unit_w(lds, u, tid, wave, lane);
            }
        }
        __builtin_amdgcn_s_setprio(0); }
        GSYNC();
        { PHASE_IDS();
        const int hd = lane >> 4;
        for (int row0 = 4 * gw; row0 < T; row0 += 4 * NGW) {
            float lse[4][3]; u32x2 dv[4][3];
#pragma unroll
            for (int q = 0; q < 4; ++q)
#pragma unroll
                for (int g = 0; g < 3; ++g) { lse[q][g] = LSEB[(size_t)g * T * 4 + (size_t)(row0 + q) * 4 + hd]; dv[q][g] = ((const u32x2*)(DPART + (size_t)g * T * 256 + (size_t)(row0 + q) * 256))[lane]; }
#pragma unroll
            for (int q = 0; q < 4; ++q) {
                const float mx = fmaxf(lse[q][0], fmaxf(lse[q][1], lse[q][2]));
                const float e0 = __builtin_amdgcn_exp2f(lse[q][0] - mx), e1 = __builtin_amdgcn_exp2f(lse[q][1] - mx), e2 = __builtin_amdgcn_exp2f(lse[q][2] - mx);
                const float inv = 1.f / (e0 + e1 + e2);
                const f32x4 od = (unpack4(dv[q][0]) * e0 + unpack4(dv[q][1]) * e1 + unpack4(dv[q][2]) * e2) * inv;
                ((u32x2*)(MIX + (size_t)(row0 + q) * 1024 + 768))[lane] = pack4(od);
            }
        } }
        GSYNC();
        { PTRS(); pg8::Gemm g{MIX, (const bf16_t*)(ws + W_OUT), T, 1024, 1024, 1024}; pg8::StaticOrder S; S.init(T, 1024, G, bid);
          pg8::EpiBf16 E{HB, 1024}; pg8::gemm_phase<pg8::EpiBf16, true>(lds, g, S, E); }
        GSYNC();
        { PHASE_IDS(); const float* MODl = MOD + (size_t)l * 8 * 6144; const float* ng = norm_g + (size_t)l * 4 * 1024;
        for (int row = 4 * gw; row < T; row += 4 * NGW) {
            const int b = row >> 12; const float* md = MODl + (size_t)b * 6144;
            if (l == 0) row_pass<4, false, true>(row, 1, x_in, HB, md + 2048, ng + 1024, (float*)(ws + WS_PROJ + 16 * MiB), ng + 2048, md + 4096, md + 3072, HB, lane);
            else row_pass<4, true, true>(row, 1, (const float*)((const bf16_t*)xout + (size_t)T * DM), HB, md + 2048, ng + 1024, (float*)(ws + WS_PROJ + 16 * MiB), ng + 2048, md + 4096, md + 3072, HB, lane);
        } }
        GSYNC();
        { PTRS(); pg8::Gemm g{HB, (const bf16_t*)(ws + W_UP), T, 2 * DFF, 1024, 1024}; pg8::StaticOrder S; S.init(T, 2 * DFF, G, bid);
          pg8::EpiConv E{ACT, (float*)(ws + WS_PROJ), ffn_conv + (size_t)l * 3 * 5632}; pg8::gemm_phase<pg8::EpiConv, true>(lds, g, S, E); }
        GSYNC();
        { PHASE_IDS();
          pg8::StaticOrder S; S.init(T, 1024, G, bid); pg8::Unit uu;
          const float* UH = (const float*)(ws + WS_PROJ);
          const float* fw = ffn_conv + (size_t)l * 3 * 5632;
          for (int i = 0; S.next(i, uu); ++i) {
              const int pm = uu.pm;
              if (tid < 352) {
                  const int c = 8 * tid, tile = c >> 7, within = c & 127, gcol = 256 * tile + within;
                  float wg[3][8], wv[3][8];
#pragma unroll
                  for (int t3 = 0; t3 < 3; ++t3) { const f32x4 a0 = *(const f32x4*)(fw + t3 * 5632 + c), a1 = *(const f32x4*)(fw + t3 * 5632 + c + 4);
                      const f32x4 b0 = *(const f32x4*)(fw + t3 * 5632 + 2816 + c), b1 = *(const f32x4*)(fw + t3 * 5632 + 2816 + c + 4);
#pragma unroll
                      for (int e = 0; e < 4; ++e) { wg[t3][e] = a0[e]; wg[t3][4 + e] = a1[e]; wv[t3][e] = b0[e]; wv[t3][4 + e] = b1[e]; } }
#pragma unroll
                  for (int which = 0; which < 2; ++which) {
                      const int row = 256 * pm + (which ? 255 : 0), s = row & (SEQ - 1);
                      const float* up_p = which ? UH + ((size_t)pm * 4 + 2) * 5632 : UH + ((size_t)(pm - 1) * 4 + 3) * 5632;
                      const bool up_ok = which ? true : (s != 0);
                      const float* cur_p = UH + ((size_t)pm * 4 + (which ? 3 : 0)) * 5632;
                      const float* dn_p = which ? UH + ((size_t)(pm + 1) * 4) * 5632 : UH + ((size_t)pm * 4 + 1) * 5632;
                      const bool dn_ok = which ? (s != SEQ - 1) : true;
                      float ug[8], uv[8];
#pragma unroll
                      for (int hf = 0; hf < 2; ++hf) {
                          const f32x4 z = {0.f, 0.f, 0.f, 0.f};
                          const f32x4 gu = up_ok ? *(const f32x4*)(up_p + gcol + 4 * hf) : z, vu = up_ok ? *(const f32x4*)(up_p + gcol + 128 + 4 * hf) : z;
                          const f32x4 gc = *(const f32x4*)(cur_p + gcol + 4 * hf), vc = *(const f32x4*)(cur_p + gcol + 128 + 4 * hf);
                          const f32x4 gd = dn_ok ? *(const f32x4*)(dn_p + gcol + 4 * hf) : z, vd = dn_ok ? *(const f32x4*)(dn_p + gcol + 128 + 4 * hf) : z;
#pragma unroll
                          for (int e = 0; e < 4; ++e) { const int k = 4 * hf + e;
                              ug[k] = wg[0][k] * gu[e] + wg[1][k] * gc[e] + wg[2][k] * gd[e];
                              uv[k] = wv[0][k] * vu[e] + wv[1][k] * vc[e] + wv[2][k] * vd[e]; }
                      }
                      u32x4 ow;
#pragma unroll
                      for (int e2 = 0; e2 < 4; ++e2) ow[e2] = pk2(gelu_tanh(ug[2 * e2]) * uv[2 * e2], gelu_tanh(ug[2 * e2 + 1]) * uv[2 * e2 + 1]);
                      *(u32x4*)(ACT + (size_t)row * DFF + c) = ow;
                  }
              }
          }
          asm volatile("s_waitcnt vmcnt(0)" ::: "memory"); __syncthreads();
        }
        { PTRS(); pg8::Gemm g{ACT, (const bf16_t*)(ws + W_DOWN), T, 1024, DFF, DFF}; pg8::StaticOrder S; S.init(T, 1024, G, bid);
          pg8::EpiBf16 E{HB, 1024}; pg8::gemm_phase<pg8::EpiBf16, true>(lds, g, S, E); }
        GSYNC();
        { PHASE_IDS(); const float* MODl = MOD + (size_t)l * 8 * 6144; const float* ng = norm_g + (size_t)l * 4 * 1024;
            const bool lastl = (l == DEPTH - 1);
            const float* MODn = MOD + (size_t)(lastl ? l : l + 1) * 8 * 6144;
            const float* ngn = norm_g + (size_t)(lastl ? l : l + 1) * 4 * 1024;
            for (int row = 4 * gw; row < T; row += 4 * NGW) {
                const int b = row >> 12; const float* md = MODl + (size_t)b * 6144; const float* mdn = MODn + (size_t)b * 6144;
                if (lastl) row_pass<4, true, false>(row, 1, (const float*)(ws + WS_PROJ + 16 * MiB), HB, md + 5120, ng + 3072, xout, ngn, mdn + 1024, mdn, nullptr, lane);
                else row_pass<4, true, true>(row, 1, (const float*)(ws + WS_PROJ + 16 * MiB), HB, md + 5120, ng + 3072, (float*)((bf16_t*)xout + (size_t)T * DM), ngn, mdn + 1024, mdn, HB, lane);
            }
            if (!lastl) convert_weights((const float*)ap_->in[7], (const float*)ap_->in[12], (const float*)ap_->in[13], (const float*)ap_->in[14], (const float*)ap_->in[15], (const float*)ap_->in[17], ws, l + 1, lds, gw, NGW, wave, lane);
        }
        if (l + 1 < DEPTH) GSYNC();
    }
}

extern "C" void kernel_launch(void* const* d_in, const int* in_sizes, int n_in, void* d_out, int out_size, void* d_ws, size_t ws_size, hipStream_t stream) {
    static int grid = 0;
    if (grid == 0) {
        if (n_in != 18 || ws_size < WS_END) { fprintf(stderr, "kernel_launch: unexpected n_in %d / ws_size %zu (need %zu)\n", n_in, ws_size, (size_t)WS_END); grid = -1; return; }
        int dev = 0, cus = 0;
        hipGetDevice(&dev); hipDeviceGetAttribute(&cus, hipDeviceAttributeMultiprocessorCount, dev);
        if (hipFuncSetAttribute((const void*)mega, hipFuncAttributeMaxDynamicSharedMemorySize, LDS_BYTES) != hipSuccess) { fprintf(stderr, "hipFuncSetAttribute failed\n"); grid = -1; return; }
        grid = cus > 0 ? cus : 256;
    }
    if (grid < 0) return;
    hipMemsetAsync(d_ws, 0, XCD_BAR_WORDS * 4, stream);
    Args a{};
    for (int i = 0; i < 18; ++i) a.in[i] = d_in[i];
    a.out = (float*)d_out; a.ws = (unsigned char*)d_ws;
    void* args[] = {&a};
    hipError_t e = hipLaunchCooperativeKernel((const void*)mega, dim3(grid), dim3(NTHREADS), args, LDS_BYTES, stream);
    if (e != hipSuccess) fprintf(stderr, "cooperative launch failed: %s (grid %d)\n", hipGetErrorString(e), grid);
}
```

```cpp
#include <hip/hip_runtime.h>
#include <hip/hip_cooperative_groups.h>
#include <cstdio>
#include <cstdint>
namespace cg = cooperative_groups;

#define LAS __attribute__((address_space(3)))
typedef unsigned short bf16_t;
typedef short bf16x8 __attribute__((ext_vector_type(8)));
typedef short s16x4 __attribute__((ext_vector_type(4)));
typedef float f32x4 __attribute__((ext_vector_type(4)));
typedef float f32x2 __attribute__((ext_vector_type(2)));
typedef float f32x16 __attribute__((ext_vector_type(16)));
typedef unsigned u32x4 __attribute__((ext_vector_type(4)));
typedef unsigned u32x2 __attribute__((ext_vector_type(2)));
typedef __bf16 bf16x2_t __attribute__((ext_vector_type(2)));

constexpr int NB = 8, SEQ = 4096, T = NB * SEQ, DM = 1024, NIN = 4096, DFF = 2816, DEPTH = 4;
constexpr int NTHREADS = 512, NWAVES = 8;
constexpr float EPS = 1e-6f, LOG2E = 1.4426950408889634f;
constexpr int PRM = 1280;
constexpr size_t HM_OFF = (size_t)T * PRM;
constexpr int UP0 = 1536, UP1 = 1280, ULD = 3072;

constexpr size_t MiB = 1u << 20;
constexpr size_t WS_MOD = 1 * MiB;
constexpr size_t MOD_BYTES = (size_t)DEPTH * NB * 6144 * 4;
constexpr size_t WS_CS = 2 * MiB;
constexpr size_t WS_LUT = 6 * MiB;
constexpr size_t WS_W = 8 * MiB;
constexpr size_t W_IN = WS_W, W_MLA = WS_W + 8 * MiB, W_OUT = WS_W + 9 * MiB, W_UP = WS_W + 11 * MiB, W_DOWN = WS_W + 22 * MiB;
constexpr size_t WS_HB = 36 * MiB;
constexpr size_t WS_PROJ = 100 * MiB;
constexpr size_t WS_ACT = 292 * MiB;
constexpr size_t WS_MIX = 356 * MiB;
constexpr size_t WS_DPART = 420 * MiB;
constexpr size_t WS_KR = 468 * MiB;
constexpr size_t WS_LSE = 470 * MiB;
constexpr size_t WS_END = 472 * MiB;

constexpr int LDS_BYTES = 131072 + 1024 + 8192;
constexpr int LDS_XB = 131072 + 1024;

__device__ __forceinline__ unsigned pk2(float lo, float hi) { f32x2 v = {lo, hi}; bf16x2_t b = __builtin_convertvector(v, bf16x2_t); return __builtin_bit_cast(unsigned, b); }
__device__ __forceinline__ float bf_lo(unsigned w) { return __uint_as_float(w << 16); }
__device__ __forceinline__ float bf_hi(unsigned w) { return __uint_as_float(w & 0xffff0000u); }
__device__ __forceinline__ float bf1(bf16_t w) { return __uint_as_float(((unsigned)w) << 16); }
__device__ __forceinline__ float wave_sum(float v) {
#pragma unroll
    for (int o = 1; o < 64; o <<= 1) v += __shfl_xor(v, o);
    return v;
}
__device__ __forceinline__ float max3f(float a, float b, float c) { float r; asm("v_max3_f32 %0, %1, %2, %3" : "=v"(r) : "v"(a), "v"(b), "v"(c)); return r; }
__device__ __forceinline__ float max2f(float a, float b) { float r; asm("v_max_f32_e32 %0, %1, %2" : "=v"(r) : "v"(a), "v"(b)); return r; }
__device__ __forceinline__ f32x4 unpack4(u32x2 w) { return (f32x4){bf_lo(w.x), bf_hi(w.x), bf_lo(w.y), bf_hi(w.y)}; }
__device__ __forceinline__ u32x2 pack4(f32x4 v) { u32x2 w; w.x = pk2(v[0], v[1]); w.y = pk2(v[2], v[3]); return w; }

__device__ __forceinline__ float gelu_tanh(float x) {
    const float t = x + 0.044715f * x * x * x;
    const float e = __builtin_amdgcn_exp2f(-2.f * 0.7978845608028654f * LOG2E * t);
    return x * __builtin_amdgcn_rcpf(1.f + e);
}
namespace pg8 {
constexpr int BM = 256, BK = 64, HALF = 128, HTB = HALF * BK * 2, STAGE_BYTES = 8 * HTB, NXCD = 8, WGM = 8;
__host__ __device__ __forceinline__ int lds_byte(int r, int c) { const int st = (r >> 4) * 2 + (c >> 5), rr = r & 15, cc = c & 31, ob = rr * 64 + cc * 2; return st * 1024 + (ob ^ (((ob >> 9) & 1) << 5)); }
__host__ __device__ __forceinline__ void stage_rc(int b, int& R, int& C) { const int st = b / 1024, sb = b % 1024, swz = sb ^ (((sb >> 9) & 1) << 5); R = (st >> 1) * 16 + swz / 64; C = (st & 1) * 32 + (swz % 64) / 2; }
__host__ __device__ __forceinline__ int perm32(int rho) { const int n = rho >> 4, i = rho & 15; return 8 * (i >> 2) + 4 * n + (i & 3); }

struct Unit { int pm, pn; };
struct Gemm { const bf16_t* A; const bf16_t* Bt; int M, N, K, lda; };

struct StaticOrder {
    int nM, nN, nwg, G, c;
    __device__ __forceinline__ void init(int M, int N, int G_, int c_) { nM = M / BM; nN = N / BM; nwg = nM * nN; G = G_; c = c_; }
    __device__ __forceinline__ bool next(int i, Unit& u) const {
        const long L = (long)i * G + c; if (L >= nwg) return false;
        int wgid = (int)L; { const int q = nwg / NXCD, r = nwg % NXCD, xcd = wgid % NXCD, off = wgid / NXCD; wgid = (xcd < r ? xcd * (q + 1) : r * (q + 1) + (xcd - r) * q) + off; }
        const int nig = WGM * nN, gid = wgid / nig, fm = gid * WGM, gsz = (nM - fm) < WGM ? (nM - fm) : WGM;
        u.pm = fm + ((wgid % nig) % gsz); u.pn = (wgid % nig) / gsz; return true;
    }
};

struct EpiBf16 {
    static constexpr bool PERM = true, NEEDS_LDS = false;
    bf16_t* O; int ldc;
    __device__ __forceinline__ void operator()(const f32x4 (&acc)[2][2][4][2], const Unit& u, int wr, int wc, int fr, int fq) const {
        const int row0 = u.pm * BM + wr * 64 + fr; const int col0 = u.pn * BM + wc * 32 + 8 * fq;
#pragma unroll
        for (int ai = 0; ai < 2; ++ai)
#pragma unroll
            for (int m = 0; m < 4; ++m) { bf16_t* rowp = O + (size_t)(row0 + ai * HALF + m * 16) * ldc + col0;
#pragma unroll
                for (int bj = 0; bj < 2; ++bj) { const f32x4 v0 = acc[ai][bj][m][0], v1 = acc[ai][bj][m][1];
                    u32x4 w; w.x = pk2(v0[0], v0[1]); w.y = pk2(v0[2], v0[3]); w.z = pk2(v1[0], v1[1]); w.w = pk2(v1[2], v1[3]);
                    *(u32x4*)(rowp + bj * HALF) = w; } }
    }
};
struct EpiProj {
    static constexpr bool PERM = true, NEEDS_LDS = false;
    bf16_t* O;
    __device__ __forceinline__ void operator()(const f32x4 (&acc)[2][2][4][2], const Unit& u, int wr, int wc, int fr, int fq) const {
        const int row0 = u.pm * BM + wr * 64 + fr; const int pn = u.pn;
        const bool rm = (pn >= 2 && pn <= 6);
        const int hm = pn < 2 ? pn : pn - 5;
        const int gsel = pn < 7 ? 0 : (pn - 7) / 3;
        const int dsh = gsel == 0 ? 0 : (gsel == 1 ? 2 : 4);
#pragma unroll
        for (int ai = 0; ai < 2; ++ai)
#pragma unroll
            for (int m = 0; m < 4; ++m) {
                const int row = row0 + ai * HALF + m * 16;
                const int b = row >> 12, s = row & (SEQ - 1);
                const int sp = ((s & ((1 << dsh) - 1)) << (12 - dsh)) + (s >> dsh);
#pragma unroll
                for (int bj = 0; bj < 2; ++bj) { const f32x4 v0 = acc[ai][bj][m][0], v1 = acc[ai][bj][m][1];
                    u32x4 w; w.x = pk2(v0[0], v0[1]); w.y = pk2(v0[2], v0[3]); w.z = pk2(v1[0], v1[1]); w.w = pk2(v1[2], v1[3]);
                    const int c = bj * HALF + wc * 32 + 8 * fq;
                    bf16_t* dst = rm ? O + (size_t)row * PRM + (pn - 2) * 256 + c
                                     : O + HM_OFF + (size_t)hm * T * 256 + ((size_t)(b * 4 + (c >> 6)) * SEQ + sp) * 64 + (c & 63);
                    *(u32x4*)dst = w; }
            }
    }
};
struct EpiMla {
    static constexpr bool PERM = false, NEEDS_LDS = false;
    bf16_t* O; int ldc; const float* cs; float qs;
    __device__ __forceinline__ void operator()(const f32x4 (&acc)[2][2][4][2], const Unit& u, int wr, int wc, int fr, int fq) const {
        const int row0 = u.pm * BM + wr * 64 + fr;
#pragma unroll
        for (int bj = 0; bj < 2; ++bj) {
            const int cgp = u.pn * 8 + bj * 4 + wc;
            const bool rope = (cgp < 12) && ((cgp % 3) == 2);
            const int col0 = cgp * 32 + 4 * fq;
#pragma unroll
            for (int ai = 0; ai < 2; ++ai)
#pragma unroll
                for (int m = 0; m < 4; ++m) {
                    const int row = row0 + ai * HALF + m * 16;
                    f32x4 v0 = acc[ai][bj][m][0], v1 = acc[ai][bj][m][1];
                    if (rope) {
                        const f32x4 c = *(const f32x4*)(cs + (size_t)row * 32 + 4 * fq), s = *(const f32x4*)(cs + (size_t)row * 32 + 16 + 4 * fq);
                        const f32x4 a = v0 * c - v1 * s, b = v1 * c + v0 * s; v0 = a; v1 = b;
                    }
                    if (cgp < 12) { v0 = v0 * qs; v1 = v1 * qs; }
                    const int bq = row >> 12, sq = row & (SEQ - 1);
                    bf16_t* rowp;
                    if (cgp < 12) rowp = O + ((size_t)(bq * 4 + cgp / 3) * SEQ + sq) * 96 + (cgp % 3) * 32 + 4 * fq;
                    else if (cgp < 20) rowp = O + (size_t)T * 384 + ((size_t)(bq * 4 + (cgp - 12) / 2) * SEQ + sq) * 64 + ((cgp - 12) & 1) * 32 + 4 * fq;
                    else rowp = O + (size_t)T * 640 + ((size_t)(bq * 4 + (cgp - 20) / 2) * SEQ + sq) * 64 + ((cgp - 20) & 1) * 32 + 4 * fq;
                    if (cgp < 28) { *(u32x2*)(rowp) = pack4(v0); *(u32x2*)(rowp + 16) = pack4(v1); }
                }
        }
    }
};

#define DPP_ROR1 0x121
#define DPP_ROR15 0x12F
#define DPP_SHR1 0x111
#define DPP_SHL1 0x101
__device__ __forceinline__ float dppf(float old, float src, const int ctrl_sel) {
    int r;
    if (ctrl_sel == 0) r = __builtin_amdgcn_update_dpp(__float_as_int(old), __float_as_int(src), DPP_ROR1, 0xf, 0xf, false);
    else if (ctrl_sel == 1) r = __builtin_amdgcn_update_dpp(__float_as_int(old), __float_as_int(src), DPP_ROR15, 0xf, 0xf, false);
    else if (ctrl_sel == 2) r = __builtin_amdgcn_update_dpp(__float_as_int(old), __float_as_int(src), DPP_SHR1, 0xf, 0xf, false);
    else r = __builtin_amdgcn_update_dpp(__float_as_int(old), __float_as_int(src), DPP_SHL1, 0xf, 0xf, false);
    return __int_as_float(r);
}
struct EpiConv {
    static constexpr bool PERM = true, NEEDS_LDS = true;
    bf16_t* ACTp; float* UH; const float* fw;
    __device__ __forceinline__ void operator()(const f32x4 (&acc)[2][2][4][2], const Unit& u, int wr, int wc, int fr, int fq, LAS unsigned char* lds) const {
        LAS float* XB = (LAS float*)(lds + LDS_XB);
        const int chl = wc * 32 + 8 * fq;
        const int ch = u.pn * 128 + chl;
#pragma unroll
        for (int ai = 0; ai < 2; ++ai) {
            const int blk = 2 * ai + wr;
#pragma unroll
            for (int bj = 0; bj < 2; ++bj)
#pragma unroll
                for (int n = 0; n < 2; ++n) {
                    if (fr == 0) *(LAS f32x4*)(XB + (2 * blk) * 256 + bj * 128 + chl + 4 * n) = acc[ai][bj][0][n];
                    if (fr == 15) *(LAS f32x4*)(XB + (2 * blk + 1) * 256 + bj * 128 + chl + 4 * n) = acc[ai][bj][3][n];
                }
        }
        float wg[3][8], wv[3][8];
#pragma unroll
        for (int t3 = 0; t3 < 3; ++t3) { const f32x4 a0 = *(const f32x4*)(fw + t3 * 5632 + ch), a1 = *(const f32x4*)(fw + t3 * 5632 + ch + 4);
            const f32x4 b0 = *(const f32x4*)(fw + t3 * 5632 + 2816 + ch), b1 = *(const f32x4*)(fw + t3 * 5632 + 2816 + ch + 4);
#pragma unroll
            for (int e = 0; e < 4; ++e) { wg[t3][e] = a0[e]; wg[t3][4 + e] = a1[e]; wv[t3][e] = b0[e]; wv[t3][4 + e] = b1[e]; } }
        asm volatile("s_waitcnt lgkmcnt(0)" ::: "memory"); __builtin_amdgcn_s_barrier(); asm volatile("" ::: "memory");
        {
            float* uh = UH + (size_t)u.pm * 4 * 5632 + u.pn * 256 + chl;
            if (wr == 0 && fr < 2) {
#pragma unroll
                for (int bj = 0; bj < 2; ++bj)
#pragma unroll
                    for (int n = 0; n < 2; ++n) *(f32x4*)(uh + (size_t)fr * 5632 + bj * 128 + 4 * n) = acc[0][bj][0][n];
            }
            if (wr == 1 && fr >= 14) {
#pragma unroll
                for (int bj = 0; bj < 2; ++bj)
#pragma unroll
                    for (int n = 0; n < 2; ++n) *(f32x4*)(uh + (size_t)(fr - 12) * 5632 + bj * 128 + 4 * n) = acc[1][bj][3][n];
            }
        }
#pragma unroll
        for (int ai = 0; ai < 2; ++ai) {
            const int blk = 2 * ai + wr;
#pragma unroll
            for (int m = 0; m < 4; ++m) {
                const int trow = 64 * blk + 16 * m + fr;
                float og[8], ov[8];
#pragma unroll
                for (int bj = 0; bj < 2; ++bj)
#pragma unroll
                    for (int n = 0; n < 2; ++n) {
                        f32x4 pv, nv;
                        if (m == 0) pv = (blk > 0) ? *(const LAS f32x4*)(XB + (2 * blk - 1) * 256 + bj * 128 + chl + 4 * n) : (f32x4){0.f, 0.f, 0.f, 0.f};
                        if (m == 3) nv = (blk < 3) ? *(const LAS f32x4*)(XB + (2 * blk + 2) * 256 + bj * 128 + chl + 4 * n) : (f32x4){0.f, 0.f, 0.f, 0.f};
#pragma unroll
                        for (int e = 0; e < 4; ++e) {
                            const float cur = acc[ai][bj][m][n][e];
                            const float upB = (m == 0) ? pv[e] : dppf(0.f, acc[ai][bj][m == 0 ? 0 : m - 1][n][e], 0);
                            const float dnB = (m == 3) ? nv[e] : dppf(0.f, acc[ai][bj][m == 3 ? 3 : m + 1][n][e], 1);
                            const float up = dppf(upB, cur, 2), dn = dppf(dnB, cur, 3);
                            const int k = 4 * n + e;
                            if (bj == 0) og[k] = wg[0][k] * up + wg[1][k] * cur + wg[2][k] * dn;
                            else         ov[k] = wv[0][k] * up + wv[1][k] * cur + wv[2][k] * dn;
                        }
                    }
                u32x4 ow;
#pragma unroll
                for (int e2 = 0; e2 < 4; ++e2) ow[e2] = pk2(gelu_tanh(og[2 * e2]) * ov[2 * e2], gelu_tanh(og[2 * e2 + 1]) * ov[2 * e2 + 1]);
                if (trow != 0 && trow != 255) *(u32x4*)(ACTp + (size_t)(u.pm * BM + trow) * DFF + ch) = ow;
            }
        }
    }
};

template <class Epi, bool ALIGN_EPI>
__device__ __forceinline__ void gemm_phase(LAS unsigned char* lds, const Gemm g, const StaticOrder& S, const Epi& E) {
    int tid = threadIdx.x; asm volatile("" : "+v"(tid));
    const int wid = __builtin_amdgcn_readfirstlane(tid >> 6), lane = tid & 63, wr = wid >> 2, wc = wid & 3, fr = lane & 15, fq = lane >> 4;
    const int K = g.K, nt = K / BK, lda = g.lda;
    unsigned voffA[2], voffB[2];
#pragma unroll
    for (int i = 0; i < 2; ++i) { int R, C; stage_rc(tid * 16 + i * 8192, R, C); const int Rb = Epi::PERM ? ((R & ~31) + perm32(R & 31)) : R;
        voffA[i] = (unsigned)(R * lda + C) * 2u; voffB[i] = (unsigned)(Rb * K + C) * 2u; }
    const size_t kstep = (size_t)(BK * 2);
    const size_t hstepA = (size_t)HALF * lda * 2, hstepB = (size_t)HALF * K * 2;
    const size_t tstepA = 2 * hstepA, tstepB = 2 * hstepB;
    const unsigned ldsw = (unsigned)wid * 1024u;
    const int aoff = lds_byte(wr * 64 + fr, fq * 8), boff = lds_byte(wc * 32 + fr, fq * 8);
#define PG8_SA(b, h) (((b) * 2 + (h)) * HTB)
#define PG8_SB(b, h) ((4 + (b) * 2 + (h)) * HTB)
#define PG8_STAGE(bufoff, gbase, voff) do { _Pragma("unroll") for (int _i = 0; _i < 2; ++_i) \
        __builtin_amdgcn_global_load_lds((const unsigned*)((const char*)(gbase) + (voff)[_i]), (LAS unsigned*)(lds + (bufoff) + ldsw + _i * 8192), 16, 0, 0); } while (0)
#define PG8_LDA(dst, b, h) do { _Pragma("unroll") for (int m = 0; m < 4; ++m) _Pragma("unroll") for (int k = 0; k < 2; ++k) dst[m][k] = *(const LAS bf16x8*)(lds + PG8_SA(b, h) + aoff + m * 2048 + k * 1024); } while (0)
#define PG8_LDB(dst, b, h) do { _Pragma("unroll") for (int n = 0; n < 2; ++n) _Pragma("unroll") for (int k = 0; k < 2; ++k) dst[n][k] = *(const LAS bf16x8*)(lds + PG8_SB(b, h) + boff + n * 2048 + k * 1024); } while (0)
#define PG8_MMA(ai, bj, At, Bt) do { __builtin_amdgcn_s_setprio(1); _Pragma("unroll") for (int m = 0; m < 4; ++m) _Pragma("unroll") for (int n = 0; n < 2; ++n) _Pragma("unroll") for (int k = 0; k < 2; ++k) \
        acc[ai][bj][m][n] = __builtin_amdgcn_mfma_f32_16x16x32_bf16(Bt[n][k], At[m][k], acc[ai][bj][m][n], 0, 0, 0); __builtin_amdgcn_s_setprio(0); } while (0)
#define PG8_WAIT_V(n) asm volatile("s_waitcnt vmcnt(" #n ")" ::: "memory")
#define PG8_WAIT_L(n) asm volatile("s_waitcnt lgkmcnt(" #n ")" ::: "memory")
#define PG8_BAR __builtin_amdgcn_s_barrier()
#define PG8_SCHED __builtin_amdgcn_sched_barrier(0)
    Unit cur, nxt; int ui = 0;
    if (!S.next(0, cur)) return;
    f32x4 acc[2][2][4][2];
#pragma unroll
    for (int a = 0; a < 2; ++a)
#pragma unroll
        for (int b = 0; b < 2; ++b)
#pragma unroll
            for (int m = 0; m < 4; ++m)
#pragma unroll
                for (int n = 0; n < 2; ++n) acc[a][b][m][n] = (f32x4){0.f, 0.f, 0.f, 0.f};
    bf16x8 At[4][2], B0[2][2], B1[2][2];
    const char* cA = (const char*)g.A + (size_t)cur.pm * tstepA; const char* cB = (const char*)g.Bt + (size_t)cur.pn * tstepB;
    PG8_STAGE(PG8_SB(0, 0), cB, voffB); PG8_STAGE(PG8_SB(0, 1), cB + hstepB, voffB); PG8_STAGE(PG8_SA(0, 0), cA, voffA); PG8_STAGE(PG8_SA(0, 1), cA + hstepA, voffA);
    if (wr == 1) PG8_BAR;
    PG8_WAIT_V(2); PG8_BAR;
    PG8_STAGE(PG8_SB(1, 0), cB + kstep, voffB); PG8_STAGE(PG8_SA(1, 0), cA + kstep, voffA); PG8_STAGE(PG8_SB(1, 1), cB + hstepB + kstep, voffB);
    PG8_WAIT_V(6); PG8_BAR;
    for (;;) {
        const bool has_next = S.next(ui + 1, nxt);
        const char* nA = has_next ? (const char*)g.A + (size_t)nxt.pm * tstepA : cA; const char* nB = has_next ? (const char*)g.Bt + (size_t)nxt.pn * tstepB : cB;
#pragma unroll 1
        for (int t = 0; t < nt; t += 2) {
            const bool last = (t == nt - 2);
            const char* a1 = cA + (size_t)(t + 1) * kstep;
            const char* a2 = last ? nA : cA + (size_t)(t + 2) * kstep; const char* b2 = last ? nB : cB + (size_t)(t + 2) * kstep;
            const char* a3 = a2 + kstep; const char* b3 = b2 + kstep;
            PG8_LDB(B0, 0, 0); PG8_LDB(B1, 0, 1); PG8_SCHED; PG8_LDA(At, 0, 0); PG8_STAGE(PG8_SA(1, 1), a1 + hstepA, voffA);
            PG8_WAIT_V(8); PG8_WAIT_L(0); PG8_BAR; PG8_MMA(0, 0, At, B0); PG8_MMA(0, 1, At, B1); PG8_BAR; PG8_SCHED;
            PG8_LDA(At, 0, 1); PG8_STAGE(PG8_SB(0, 0), b2, voffB); PG8_STAGE(PG8_SB(0, 1), b2 + hstepB, voffB); PG8_STAGE(PG8_SA(0, 0), a2, voffA);
            PG8_WAIT_V(8); PG8_WAIT_L(0); PG8_BAR; PG8_MMA(1, 0, At, B0); PG8_MMA(1, 1, At, B1); PG8_BAR; PG8_SCHED;
            PG8_LDB(B0, 1, 0); PG8_LDB(B1, 1, 1); PG8_SCHED; PG8_LDA(At, 1, 0); PG8_STAGE(PG8_SA(0, 1), a2 + hstepA, voffA);
            PG8_WAIT_V(8); PG8_WAIT_L(0); PG8_BAR; PG8_MMA(0, 0, At, B0); PG8_MMA(0, 1, At, B1); PG8_BAR; PG8_SCHED;
            PG8_LDA(At, 1, 1); PG8_STAGE(PG8_SB(1, 0), b3, voffB); PG8_STAGE(PG8_SB(1, 1), b3 + hstepB, voffB); PG8_STAGE(PG8_SA(1, 0), a3, voffA);
            PG8_WAIT_V(8); PG8_WAIT_L(0); PG8_BAR; PG8_MMA(1, 0, At, B0); PG8_MMA(1, 1, At, B1); PG8_BAR; PG8_SCHED;
        }
        if constexpr (ALIGN_EPI) { if (wr == 0) PG8_BAR; }
        if constexpr (Epi::NEEDS_LDS) E(acc, cur, wr, wc, fr, fq, lds); else E(acc, cur, wr, wc, fr, fq);
        if (!has_next) break;
#pragma unroll
        for (int a = 0; a < 2; ++a)
#pragma unroll
            for (int b = 0; b < 2; ++b)
#pragma unroll
                for (int m = 0; m < 4; ++m)
#pragma unroll
                    for (int n = 0; n < 2; ++n) acc[a][b][m][n] = (f32x4){0.f, 0.f, 0.f, 0.f};
        cur = nxt; cA = nA; cB = nB; ++ui;
        if constexpr (ALIGN_EPI) { if (wr == 1) PG8_BAR; }
    }
    PG8_WAIT_V(0);
    if constexpr (!ALIGN_EPI) { if (wr == 0) PG8_BAR; }
    PG8_BAR;
#undef PG8_SA
#undef PG8_SB
#undef PG8_STAGE
#undef PG8_LDA
#undef PG8_LDB
#undef PG8_MMA
#undef PG8_WAIT_V
#undef PG8_WAIT_L
#undef PG8_BAR
#undef PG8_SCHED
}
}

__device__ __forceinline__ void store_row_t21(bf16_t* ob, const f32x16& o0, const f32x16& o1, float inv, int h) {
#pragma unroll
    for (int db = 0; db < 2; ++db)
#pragma unroll
        for (int gp = 0; gp < 2; ++gp) {
            const int g0 = 2 * gp, g1 = 2 * gp + 1;
            u32x2 a, b;
            if (db == 0) { a.x = pk2(o0[4 * g0] * inv, o0[4 * g0 + 1] * inv); a.y = pk2(o0[4 * g0 + 2] * inv, o0[4 * g0 + 3] * inv);
                           b.x = pk2(o0[4 * g1] * inv, o0[4 * g1 + 1] * inv); b.y = pk2(o0[4 * g1 + 2] * inv, o0[4 * g1 + 3] * inv); }
            else         { a.x = pk2(o1[4 * g0] * inv, o1[4 * g0 + 1] * inv); a.y = pk2(o1[4 * g0 + 2] * inv, o1[4 * g0 + 3] * inv);
                           b.x = pk2(o1[4 * g1] * inv, o1[4 * g1 + 1] * inv); b.y = pk2(o1[4 * g1 + 2] * inv, o1[4 * g1 + 3] * inv); }
            { auto r = __builtin_amdgcn_permlane32_swap(a.x, b.x, false, false); a.x = r[0]; b.x = r[1]; }
            { auto r = __builtin_amdgcn_permlane32_swap(a.y, b.y, false, false); a.y = r[0]; b.y = r[1]; }
            u32x4 w; w.x = a.x; w.y = a.y; w.z = b.x; w.w = b.y;
            *(u32x4*)(ob + 32 * db + 16 * gp + 8 * h) = w;
        }
}
struct AU {
    const bf16_t* Q; const bf16_t* K1; const bf16_t* K2; const bf16_t* V; bf16_t* O; float* LSE; const float* lut;
    int qpitch, k1pitch, k2pitch, vpitch, opitch, lsepitch;
    int R, q0, kt_lo, kt_hi;
    float sc, m0, l0;
};
constexpr int AT_KBUF = 64 * 208, AT_VBUF = 64 * 192, AT_LUT = 2 * AT_KBUF + 2 * AT_VBUF, AT_PAD = 128;

template <int DK, bool BANDED>
__device__ __forceinline__ void attn_unit(LAS unsigned char* lds, const AU& u, int tid, int wid, int lane) {
    constexpr int KP = DK * 2 + 16, VP = 192, NKS = DK / 16;
    const int r = lane & 31, h = lane >> 5;
    const int qidx = u.q0 + 32 * wid + r;
    LAS float* lut = (LAS float*)(lds + AT_LUT);
    if (BANDED) { for (int i = tid; i < 2 * u.R + 1 + 2 * AT_PAD; i += NTHREADS) { const int j = i - AT_PAD; lut[i] = (j >= 0 && j <= 2 * u.R) ? u.lut[j] : -1e30f; } }
    bf16x8 qf[NKS];
    { const bf16_t* qp = u.Q + (size_t)qidx * u.qpitch + 8 * h;
#pragma unroll
      for (int ks = 0; ks < NKS; ++ks) qf[ks] = *(const bf16x8*)(qp + 16 * ks); }
    float m = u.m0, l = u.l0;
    f32x16 o0, o1;
#pragma unroll
    for (int i = 0; i < 16; ++i) { o0[i] = 0.f; o1[i] = 0.f; }
    const int skey = tid >> 3, sch = tid & 7, skey2 = tid >> 2, sch2 = tid & 3;
    u32x4 kreg, vreg, k2reg = {0u, 0u, 0u, 0u};
#define AT_LOAD(kt_) do { const size_t key_ = (size_t)(64 * (kt_) + skey); \
        kreg = *(const u32x4*)(u.K1 + key_ * u.k1pitch + 8 * sch); vreg = *(const u32x4*)(u.V + key_ * u.vpitch + 8 * sch); \
        if (DK == 96 && tid < 256) k2reg = *(const u32x4*)(u.K2 + (size_t)(64 * (kt_) + skey2) * u.k2pitch + 8 * sch2); } while (0)
    const int qlo = u.q0 + 32 * wid, qhi = qlo + 31;
    AT_LOAD(u.kt_lo);
    for (int kt = u.kt_lo; kt < u.kt_hi; ++kt) {
        const int buf = (kt - u.kt_lo) & 1;
        LAS unsigned char* Kb = lds + buf * AT_KBUF; LAS unsigned char* Vb = lds + 2 * AT_KBUF + buf * AT_VBUF;
        *(LAS u32x4*)(Kb + skey * KP + 16 * sch) = kreg;
        *(LAS u32x4*)(Vb + skey * VP + 16 * sch) = vreg;
        if (DK == 96 && tid < 256) *(LAS u32x4*)(Kb + skey2 * KP + 128 + 16 * sch2) = k2reg;
        __syncthreads();
        if (kt + 1 < u.kt_hi) AT_LOAD(kt + 1);
        const bool active = !BANDED || ((64 * kt + 63 >= qlo - u.R) && (64 * kt <= qhi + u.R));
        if (active) {
            f32x16 p0, p1;
#pragma unroll
            for (int i = 0; i < 16; ++i) { p0[i] = 0.f; p1[i] = 0.f; }
#pragma unroll
            for (int ks = 0; ks < NKS; ++ks) {
                const bf16x8 a0 = *(const LAS bf16x8*)(Kb + r * KP + (16 * ks + 8 * h) * 2);
                const bf16x8 a1 = *(const LAS bf16x8*)(Kb + (32 + r) * KP + (16 * ks + 8 * h) * 2);
                p0 = __builtin_amdgcn_mfma_f32_32x32x16_bf16(a0, qf[ks], p0, 0, 0, 0);
                p1 = __builtin_amdgcn_mfma_f32_32x32x16_bf16(a1, qf[ks], p1, 0, 0, 0);
            }
            __builtin_amdgcn_sched_barrier(0);
            float mx = -1e30f;
            const LAS float* lb = lut + (64 * kt + 4 * h - qidx + u.R + AT_PAD);
#pragma unroll
            for (int i = 0; i < 16; ++i) {
                float s0 = p0[i] * u.sc, s1 = p1[i] * u.sc;
                if (BANDED) { s0 += lb[(i & 3) + 8 * (i >> 2)]; s1 += lb[32 + (i & 3) + 8 * (i >> 2)]; }
                p0[i] = s0; p1[i] = s1; mx = fmaxf(mx, fmaxf(s0, s1));
            }
            mx = fmaxf(mx, __shfl_xor(mx, 32));
            const float mn = fmaxf(m, mx), alpha = __builtin_amdgcn_exp2f(m - mn); m = mn;
            float rs = 0.f;
#pragma unroll
            for (int i = 0; i < 16; ++i) { p0[i] = __builtin_amdgcn_exp2f(p0[i] - mn); p1[i] = __builtin_amdgcn_exp2f(p1[i] - mn); rs += p0[i] + p1[i]; }
            rs += __shfl_xor(rs, 32);
            l = l * alpha + rs;
#pragma unroll
            for (int i = 0; i < 16; ++i) { o0[i] *= alpha; o1[i] *= alpha; }
            __builtin_amdgcn_sched_barrier(0);
            const int trow = 4 * h + ((lane & 15) >> 2), tcol = (16 * ((lane >> 4) & 1) + 4 * (lane & 3)) * 2;
#pragma unroll
            for (int hf = 0; hf < 2; ++hf)
#pragma unroll
                for (int s = 0; s < 2; ++s) {
                    u32x4 xw;
                    if (hf == 0) { xw.x = pk2(p0[8 * s], p0[8 * s + 1]); xw.y = pk2(p0[8 * s + 2], p0[8 * s + 3]); xw.z = pk2(p0[8 * s + 4], p0[8 * s + 5]); xw.w = pk2(p0[8 * s + 6], p0[8 * s + 7]); }
                    else         { xw.x = pk2(p1[8 * s], p1[8 * s + 1]); xw.y = pk2(p1[8 * s + 2], p1[8 * s + 3]); xw.z = pk2(p1[8 * s + 4], p1[8 * s + 5]); xw.w = pk2(p1[8 * s + 6], p1[8 * s + 7]); }
                    const bf16x8 xs = __builtin_bit_cast(bf16x8, xw);
                    const LAS unsigned char* vp = Vb + (32 * hf + 16 * s + trow) * VP + tcol;
                    const s16x4 lo0 = __builtin_bit_cast(s16x4, __builtin_amdgcn_ds_read_tr16_b64_v4i16((LAS s16x4*)(vp)));
                    const s16x4 hi0 = __builtin_bit_cast(s16x4, __builtin_amdgcn_ds_read_tr16_b64_v4i16((LAS s16x4*)(vp + 8 * VP)));
                    const s16x4 lo1 = __builtin_bit_cast(s16x4, __builtin_amdgcn_ds_read_tr16_b64_v4i16((LAS s16x4*)(vp + 64)));
                    const s16x4 hi1 = __builtin_bit_cast(s16x4, __builtin_amdgcn_ds_read_tr16_b64_v4i16((LAS s16x4*)(vp + 8 * VP + 64)));
                    const bf16x8 pa0 = __builtin_shufflevector(lo0, hi0, 0, 1, 2, 3, 4, 5, 6, 7);
                    const bf16x8 pa1 = __builtin_shufflevector(lo1, hi1, 0, 1, 2, 3, 4, 5, 6, 7);
                    o0 = __builtin_amdgcn_mfma_f32_32x32x16_bf16(pa0, xs, o0, 0, 0, 0);
                    o1 = __builtin_amdgcn_mfma_f32_32x32x16_bf16(pa1, xs, o1, 0, 0, 0);
                }
        }
    }
#undef AT_LOAD
    {
        const float inv = 1.f / l;
        bf16_t* op = u.O + (size_t)qidx * u.opitch + 4 * h;
#pragma unroll
        for (int g = 0; g < 4; ++g) {
            u32x2 w0, w1;
            w0.x = pk2(o0[4 * g] * inv, o0[4 * g + 1] * inv); w0.y = pk2(o0[4 * g + 2] * inv, o0[4 * g + 3] * inv);
            w1.x = pk2(o1[4 * g] * inv, o1[4 * g + 1] * inv); w1.y = pk2(o1[4 * g + 2] * inv, o1[4 * g + 3] * inv);
            *(u32x2*)(op + 8 * g) = w0; *(u32x2*)(op + 32 + 8 * g) = w1;
        }
        if (u.LSE && h == 0) u.LSE[(size_t)qidx * u.lsepitch] = m + __builtin_amdgcn_logf(l);
    }
    __syncthreads();
}


constexpr int AC_KP = 208, AC_VP = 192, AC_KBUF = 64 * AC_KP, AC_VBUF = 64 * AC_VP, AC_VOFF = 2 * AC_KBUF;
__device__ __forceinline__ void attn_unit_c(LAS unsigned char* lds, const AU& u, int tid, int wid, int lane) {
    constexpr int NT = SEQ / 64;
    const int r = lane & 31, h = lane >> 5;
    const int qidx = u.q0 + 32 * wid + r;
    bf16x8 qf[6];
    { const bf16_t* qp = u.Q + (size_t)qidx * u.qpitch + 8 * h;
#pragma unroll
      for (int ks = 0; ks < 6; ++ks) qf[ks] = *(const bf16x8*)(qp + 16 * ks); }
    float m = -1e30f, l = 0.f;
    f32x16 o0, o1;
#pragma unroll
    for (int i = 0; i < 16; ++i) { o0[i] = 0.f; o1[i] = 0.f; }
    const int skey = tid >> 3, sch = tid & 7, skey2 = tid >> 2, sch2 = tid & 3;
    u32x4 kreg, vreg, k2reg = {0u, 0u, 0u, 0u};
    const bf16_t* kp1 = u.K1 + (size_t)skey * u.k1pitch + 8 * sch;
    const bf16_t* vp1 = u.V + (size_t)skey * u.vpitch + 8 * sch;
    const bf16_t* kp2 = u.K2 + (size_t)skey2 * u.k2pitch + 8 * sch2;
#define AC_LOAD(kt_) do { kreg = *(const u32x4*)(kp1 + (size_t)(64 * (kt_)) * u.k1pitch); vreg = *(const u32x4*)(vp1 + (size_t)(64 * (kt_)) * u.vpitch); \
        if (tid < 256) k2reg = *(const u32x4*)(kp2 + (size_t)(64 * (kt_)) * u.k2pitch); } while (0)
#define AC_STORE(kt_) do { LAS unsigned char* Kb_ = lds + ((kt_) & 1) * AC_KBUF; LAS unsigned char* Vb_ = lds + AC_VOFF + ((kt_) % 3) * AC_VBUF; \
        *(LAS u32x4*)(Kb_ + skey * AC_KP + 16 * sch) = kreg; *(LAS u32x4*)(Vb_ + skey * AC_VP + 16 * sch) = vreg; \
        if (tid < 256) *(LAS u32x4*)(Kb_ + skey2 * AC_KP + 128 + 16 * sch2) = k2reg; } while (0)
#define AC_QK(P0, P1, kt_) do { const LAS unsigned char* Kb_ = lds + ((kt_) & 1) * AC_KBUF + r * AC_KP + 16 * h; \
        bf16x8 ka_[6], kb_[6]; \
        _Pragma("unroll") for (int ks = 0; ks < 6; ++ks) { ka_[ks] = *(const LAS bf16x8*)(Kb_ + 32 * ks); kb_[ks] = *(const LAS bf16x8*)(Kb_ + 32 * AC_KP + 32 * ks); } \
        _Pragma("unroll") for (int i_ = 0; i_ < 16; ++i_) { P0[i_] = negm; P1[i_] = negm; } \
        _Pragma("unroll") for (int ks = 0; ks < 6; ++ks) { \
            P0 = __builtin_amdgcn_mfma_f32_32x32x16_bf16(ka_[ks], qf[ks], P0, 0, 0, 0); P1 = __builtin_amdgcn_mfma_f32_32x32x16_bf16(kb_[ks], qf[ks], P1, 0, 0, 0); } } while (0)
    const int trow = 4 * h + ((lane & 15) >> 2), tcol = (16 * ((lane >> 4) & 1) + 4 * (lane & 3)) * 2;
#define AC_SOFTMAX_PV(P0, P1, N0, N1, kt_) do { \
          \
        float rq_[4] = {0.f, 0.f, 0.f, 0.f}; int mq_[4];     \
        _Pragma("unroll") for (int i_ = 0; i_ < 16; ++i_) { P0[i_] = __builtin_amdgcn_exp2f(P0[i_]); P1[i_] = __builtin_amdgcn_exp2f(P1[i_]); rq_[i_ & 3] += P0[i_] + P1[i_]; \
            if (i_ < 4) mq_[i_] = max(__float_as_int(P0[i_]), __float_as_int(P1[i_])); else mq_[i_ & 3] = max(max(mq_[i_ & 3], __float_as_int(P0[i_])), __float_as_int(P1[i_])); } \
        const LAS unsigned char* Vb_ = lds + AC_VOFF + ((kt_) % 3) * AC_VBUF + trow * AC_VP + tcol; \
        s16x4 vl0_[4], vh0_[4], vl1_[4], vh1_[4]; \
        _Pragma("unroll") for (int q_ = 0; q_ < 4; ++q_) { const LAS unsigned char* vp_ = Vb_ + (16 * q_) * AC_VP; \
            vl0_[q_] = __builtin_bit_cast(s16x4, __builtin_amdgcn_ds_read_tr16_b64_v4i16((LAS s16x4*)(vp_))); \
            vh0_[q_] = __builtin_bit_cast(s16x4, __builtin_amdgcn_ds_read_tr16_b64_v4i16((LAS s16x4*)(vp_ + 8 * AC_VP))); \
            vl1_[q_] = __builtin_bit_cast(s16x4, __builtin_amdgcn_ds_read_tr16_b64_v4i16((LAS s16x4*)(vp_ + 64))); \
            vh1_[q_] = __builtin_bit_cast(s16x4, __builtin_amdgcn_ds_read_tr16_b64_v4i16((LAS s16x4*)(vp_ + 8 * AC_VP + 64))); } \
        _Pragma("unroll") for (int hf = 0; hf < 2; ++hf) _Pragma("unroll") for (int s = 0; s < 2; ++s) { \
            u32x4 xw_; \
            if (hf == 0) { xw_.x = pk2(P0[8 * s], P0[8 * s + 1]); xw_.y = pk2(P0[8 * s + 2], P0[8 * s + 3]); xw_.z = pk2(P0[8 * s + 4], P0[8 * s + 5]); xw_.w = pk2(P0[8 * s + 6], P0[8 * s + 7]); } \
            else         { xw_.x = pk2(P1[8 * s], P1[8 * s + 1]); xw_.y = pk2(P1[8 * s + 2], P1[8 * s + 3]); xw_.z = pk2(P1[8 * s + 4], P1[8 * s + 5]); xw_.w = pk2(P1[8 * s + 6], P1[8 * s + 7]); } \
            const bf16x8 xs_ = __builtin_bit_cast(bf16x8, xw_); \
            o0 = __builtin_amdgcn_mfma_f32_32x32x16_bf16(__builtin_shufflevector(vl0_[2 * hf + s], vh0_[2 * hf + s], 0, 1, 2, 3, 4, 5, 6, 7), xs_, o0, 0, 0, 0); \
            o1 = __builtin_amdgcn_mfma_f32_32x32x16_bf16(__builtin_shufflevector(vl1_[2 * hf + s], vh1_[2 * hf + s], 0, 1, 2, 3, 4, 5, 6, 7), xs_, o1, 0, 0, 0); } \
        float rs_ = (rq_[0] + rq_[1]) + (rq_[2] + rq_[3]); \
        rs_ += __shfl_xor(rs_, 32); l += rs_; \
        int emi_ = max(max(max(mq_[0], mq_[1]), mq_[2]), mq_[3]); \
        emi_ = max(emi_, __shfl_xor(emi_, 32)); \
        const float em_ = __int_as_float(emi_); \
        if ((kt_) == 0 || __builtin_amdgcn_ballot_w64(em_ > 256.0f) != 0ull) { \
            const float ec_ = (kt_) == 0 ? fmaxf(em_, 1e-30f) : fmaxf(em_, 1.f); \
            const float dl_ = __builtin_amdgcn_logf(ec_), al_ = __builtin_amdgcn_exp2f(-dl_); l *= al_; \
            _Pragma("unroll") for (int i_ = 0; i_ < 16; ++i_) { o0[i_] *= al_; o1[i_] *= al_; N0[i_] -= dl_; N1[i_] -= dl_; } negm -= dl_; } } while (0)
    f32x16 pA0, pA1, pB0, pB1; float negm = 0.f;
#pragma unroll
    for (int i = 0; i < 16; ++i) { pB0[i] = 0.f; pB1[i] = 0.f; }
    AC_LOAD(0); AC_STORE(0);
    __syncthreads();
    AC_LOAD(1);
    AC_QK(pA0, pA1, 0);
    for (int t = 0; t < NT; t += 2) {
        AC_STORE(t + 1);
        __syncthreads();
        if (t + 2 < NT) AC_LOAD(t + 2);
        AC_QK(pB0, pB1, t + 1);
        AC_SOFTMAX_PV(pA0, pA1, pB0, pB1, t);
        if (t + 2 < NT) AC_STORE(t + 2);
        __syncthreads();
        if (t + 3 < NT) AC_LOAD(t + 3);
        if (t + 2 < NT) AC_QK(pA0, pA1, t + 2);
        AC_SOFTMAX_PV(pB0, pB1, pA0, pA1, t + 1);
    }
#undef AC_LOAD
#undef AC_STORE
#undef AC_QK
#undef AC_SOFTMAX_PV
    {
        const float inv = 1.f / l;
        store_row_t21(u.O + (size_t)qidx * u.opitch, o0, o1, inv, h);
    }
    __syncthreads();
}

constexpr int BW_VP = 192, BW_VBYTES = 64 * BW_VP, BW_LUT = 8 * BW_VBYTES;
__device__ __forceinline__ void attn_unit_w(LAS unsigned char* lds, const AU& u, int tid, int wid, int lane) {
    const int r = lane & 31, h = lane >> 5;
    const int qidx = u.q0 + 32 * wid + r;
    LAS float* lut = (LAS float*)(lds + BW_LUT);
    for (int i = tid; i < 2 * u.R + 1 + 2 * AT_PAD; i += NTHREADS) { const int j = i - AT_PAD; lut[i] = (j >= 0 && j <= 2 * u.R) ? u.lut[j] : -1e30f; }
    bf16x8 qf[4];
    { const bf16_t* qp = u.Q + (size_t)qidx * u.qpitch + 8 * h;
#pragma unroll
      for (int ks = 0; ks < 4; ++ks) qf[ks] = *(const bf16x8*)(qp + 16 * ks); }
    float m = u.m0, l = u.l0;
    f32x16 o0, o1;
#pragma unroll
    for (int i = 0; i < 16; ++i) { o0[i] = 0.f; o1[i] = 0.f; }
    const int qlo = u.q0 + 32 * wid;
    int t_lo = (qlo - u.R) >> 6, t_hi = ((qlo + 31 + u.R) >> 6) + 1;
    t_lo = t_lo < u.kt_lo ? u.kt_lo : t_lo; t_hi = t_hi > u.kt_hi ? u.kt_hi : t_hi;
    LAS unsigned char* Vw = lds + wid * BW_VBYTES;
    const int vkey = lane >> 3, vch = lane & 7;
    bf16x8 kf[8]; u32x4 vr[8];
    const bf16_t* kbase = u.K1 + (size_t)r * u.k1pitch + 8 * h;
    const bf16_t* vbase = u.V + (size_t)vkey * u.vpitch + 8 * vch;
#define BW_LOAD(t_) do { const bf16_t* kp_ = kbase + (size_t)(64 * (t_)) * u.k1pitch; const bf16_t* vp_ = vbase + (size_t)(64 * (t_)) * u.vpitch; \
        _Pragma("unroll") for (int ks = 0; ks < 4; ++ks) { kf[ks] = *(const bf16x8*)(kp_ + 16 * ks); kf[4 + ks] = *(const bf16x8*)(kp_ + (size_t)32 * u.k1pitch + 16 * ks); } \
        _Pragma("unroll") for (int j = 0; j < 8; ++j) vr[j] = *(const u32x4*)(vp_ + (size_t)(8 * j) * u.vpitch); } while (0)
    __syncthreads();
    if (t_lo < t_hi) BW_LOAD(t_lo);
    const int trow = 4 * h + ((lane & 15) >> 2), tcol = (16 * ((lane >> 4) & 1) + 4 * (lane & 3)) * 2;
    for (int kt = t_lo; kt < t_hi; ++kt) {
#pragma unroll
        for (int j = 0; j < 8; ++j) *(LAS u32x4*)(Vw + (vkey + 8 * j) * BW_VP + 16 * vch) = vr[j];
        bf16x8 kc[8];
#pragma unroll
        for (int i = 0; i < 8; ++i) kc[i] = kf[i];
        if (kt + 1 < t_hi) BW_LOAD(kt + 1);
        f32x16 p0, p1;
#pragma unroll
        for (int i = 0; i < 16; ++i) { p0[i] = 0.f; p1[i] = 0.f; }
#pragma unroll
        for (int ks = 0; ks < 4; ++ks) {
            p0 = __builtin_amdgcn_mfma_f32_32x32x16_bf16(kc[ks], qf[ks], p0, 0, 0, 0);
            p1 = __builtin_amdgcn_mfma_f32_32x32x16_bf16(kc[4 + ks], qf[ks], p1, 0, 0, 0);
        }
        const LAS float* lb = lut + (64 * kt + 4 * h - qidx + u.R + AT_PAD);
        float mq[4] = {-1e30f, -1e30f, -1e30f, -1e30f};
#pragma unroll
        for (int i = 0; i < 16; ++i) {
            const float s0 = p0[i] * u.sc + lb[(i & 3) + 8 * (i >> 2)], s1 = p1[i] * u.sc + lb[32 + (i & 3) + 8 * (i >> 2)];
            p0[i] = s0; p1[i] = s1; mq[i & 3] = max3f(mq[i & 3], s0, s1);
        }
        float mx = max2f(max3f(mq[0], mq[1], mq[2]), mq[3]);
        mx = max2f(mx, __shfl_xor(mx, 32));
        const float mn = fmaxf(m, mx), alpha = __builtin_amdgcn_exp2f(m - mn); m = mn;
        float rq[4] = {0.f, 0.f, 0.f, 0.f};
#pragma unroll
        for (int i = 0; i < 16; ++i) { p0[i] = __builtin_amdgcn_exp2f(p0[i] - mn); p1[i] = __builtin_amdgcn_exp2f(p1[i] - mn); rq[i & 3] += p0[i] + p1[i]; }
        float rs = (rq[0] + rq[1]) + (rq[2] + rq[3]);
        rs += __shfl_xor(rs, 32);
        l = l * alpha + rs;
#pragma unroll
        for (int i = 0; i < 16; ++i) { o0[i] *= alpha; o1[i] *= alpha; }
#pragma unroll
        for (int hf = 0; hf < 2; ++hf)
#pragma unroll
            for (int s = 0; s < 2; ++s) {
                u32x4 xw;
                if (hf == 0) { xw.x = pk2(p0[8 * s], p0[8 * s + 1]); xw.y = pk2(p0[8 * s + 2], p0[8 * s + 3]); xw.z = pk2(p0[8 * s + 4], p0[8 * s + 5]); xw.w = pk2(p0[8 * s + 6], p0[8 * s + 7]); }
                else         { xw.x = pk2(p1[8 * s], p1[8 * s + 1]); xw.y = pk2(p1[8 * s + 2], p1[8 * s + 3]); xw.z = pk2(p1[8 * s + 4], p1[8 * s + 5]); xw.w = pk2(p1[8 * s + 6], p1[8 * s + 7]); }
                const bf16x8 xs = __builtin_bit_cast(bf16x8, xw);
                const LAS unsigned char* vp = Vw + (32 * hf + 16 * s + trow) * BW_VP + tcol;
                const s16x4 lo0 = __builtin_bit_cast(s16x4, __builtin_amdgcn_ds_read_tr16_b64_v4i16((LAS s16x4*)(vp)));
                const s16x4 hi0 = __builtin_bit_cast(s16x4, __builtin_amdgcn_ds_read_tr16_b64_v4i16((LAS s16x4*)(vp + 8 * BW_VP)));
                const s16x4 lo1 = __builtin_bit_cast(s16x4, __builtin_amdgcn_ds_read_tr16_b64_v4i16((LAS s16x4*)(vp + 64)));
                const s16x4 hi1 = __builtin_bit_cast(s16x4, __builtin_amdgcn_ds_read_tr16_b64_v4i16((LAS s16x4*)(vp + 8 * BW_VP + 64)));
                o0 = __builtin_amdgcn_mfma_f32_32x32x16_bf16(__builtin_shufflevector(lo0, hi0, 0, 1, 2, 3, 4, 5, 6, 7), xs, o0, 0, 0, 0);
                o1 = __builtin_amdgcn_mfma_f32_32x32x16_bf16(__builtin_shufflevector(lo1, hi1, 0, 1, 2, 3, 4, 5, 6, 7), xs, o1, 0, 0, 0);
            }
    }
#undef BW_LOAD
    {
        int qidx2 = u.q0 + 32 * wid + r; asm volatile("" : "+v"(qidx2));
        const float inv = 1.f / l;
        store_row_t21(u.O + (size_t)qidx2 * u.opitch, o0, o1, inv, h);
        if (u.LSE && h == 0) u.LSE[(size_t)qidx2 * u.lsepitch] = m + __builtin_amdgcn_logf(l);
    }
    __syncthreads();
}

struct Args { const void* in[18]; float* out; unsigned char* ws; };

__device__ __forceinline__ void tr_item(const float* W, int ldw, int k0, int n0, bf16_t* D, int ldd, int drow0, int dk0, LAS float* scr, int lane) {
    if (W) {
        float tv_[32];
#pragma unroll
        for (int i = 0; i < 32; ++i) { const int kk = 2 * i + (lane >> 5); tv_[i] = W[(size_t)(k0 + kk) * ldw + n0 + (lane & 31)]; }
#pragma unroll
        for (int i = 0; i < 32; ++i) { const int kk = 2 * i + (lane >> 5); scr[kk * 33 + (lane & 31)] = tv_[i]; }
    }
    asm volatile("s_waitcnt lgkmcnt(0)" ::: "memory");
    const int c = lane & 7;
#pragma unroll
    for (int j = 0; j < 4; ++j) { const int n = (lane >> 3) + 8 * j; const LAS float* s = scr + (8 * c) * 33 + n;
        unsigned z_ = 0u; asm volatile("" : "+v"(z_)); u32x4 o = {z_, z_, z_, z_};
        if (W) { o.x = pk2(s[0 * 33], s[1 * 33]); o.y = pk2(s[2 * 33], s[3 * 33]); o.z = pk2(s[4 * 33], s[5 * 33]); o.w = pk2(s[6 * 33], s[7 * 33]); }
        *(u32x4*)(D + (size_t)(drow0 + n) * ldd + dk0 + 8 * c) = o; }
    asm volatile("s_waitcnt lgkmcnt(0)" ::: "memory");
}

__device__ __forceinline__ void convert_weights(const float* w_in_, const float* w_uq_, const float* w_ukv_, const float* w_out_, const float* w_up_, const float* w_down_, unsigned char* ws_, int l, LAS unsigned char* lds, int gw, int NGW, int wave, int lane) {
    LAS float* scr = (LAS float*)(lds + wave * 16384);
    unsigned char* ws = ws_;
    const float* w_in = w_in_ + (size_t)l * 1024 * 4000;
    const float* w_uq = w_uq_ + (size_t)l * 256 * 384;
    const float* w_ukv = w_ukv_ + (size_t)l * 128 * 512;
    const float* w_out = w_out_ + (size_t)l * 1024 * 1024;
    const float* w_up = w_up_ + (size_t)l * 1024 * 5632;
    const float* w_down = w_down_ + (size_t)l * 2816 * 1024;
    constexpr int I_IN = 16 * 125, I_OUT = 16 * 32, I_UP = 16 * 176, I_DOWN = 44 * 32, I_MLA = 6 * 32;
    constexpr int NIT = I_IN + I_OUT + I_UP + I_DOWN + I_MLA;
    for (int it = gw; it < NIT; it += NGW) {
        int r = it;
        if (r < I_UP) { const int kb = r / 176, nb = r % 176; const int n0 = 32 * nb;
            int drow; { const int c = n0 < 2816 ? n0 : n0 - 2816; drow = 256 * (c >> 7) + (c & 127) + (n0 < 2816 ? 0 : 128); }
            tr_item(w_up, 5632, 64 * kb, n0, (bf16_t*)(ws + W_UP), 1024, drow, 64 * kb, scr, lane); continue; } r -= I_UP;
        if (r < I_IN) { const int kb = r / 125, nb = r % 125; tr_item(w_in, 4000, 64 * kb, 32 * nb, (bf16_t*)(ws + W_IN), 1024, 32 * nb + (32 * nb >= 1696 ? 96 : 0), 64 * kb, scr, lane); continue; } r -= I_IN;
        if (r < I_DOWN) { const int kb = r / 32, nb = r % 32; tr_item(w_down, 1024, 64 * kb, 32 * nb, (bf16_t*)(ws + W_DOWN), 2816, 32 * nb, 64 * kb, scr, lane); continue; } r -= I_DOWN;
        if (r < I_OUT) { const int kb = r / 32, nb = r % 32; tr_item(w_out, 1024, 64 * kb, 32 * nb, (bf16_t*)(ws + W_OUT), 1024, 32 * nb, 64 * kb, scr, lane); continue; } r -= I_OUT;
        { const int kb = r / 32, nb = r % 32, n0 = 32 * nb; const float* W = nullptr; int ldw = 0, k0 = 0, sn0 = 0;
          if (n0 < 384) { if (kb < 4) { W = w_uq; ldw = 384; k0 = 64 * kb; sn0 = n0; } }
          else if (n0 < 896) { if (kb >= 4) { W = w_ukv; ldw = 512; k0 = 64 * (kb - 4);
                  if (n0 < 640) { const int hk = (n0 - 384) / 64, e0 = (n0 - 384) % 64; sn0 = hk * 128 + e0; } else { const int hv = (n0 - 640) / 64, e0 = (n0 - 640) % 64; sn0 = hv * 128 + 64 + e0; } } }
          tr_item(W, ldw, k0, sn0, (bf16_t*)(ws + W_MLA), 384, n0, 64 * kb, scr, lane); }
    }
}

template <int NR, bool XIN16 = false, bool XOUT16 = false>
__device__ __forceinline__ void row_pass(int row, int rstride, const float* xin, const bf16_t* y, const float* gate, const float* gainY, float* xout,
                                         const float* gainH, const float* sc, const float* sh, bf16_t* hout, int lane) {
    f32x4 xv[NR][4]; f32x4 yv[NR][4];
#pragma unroll
    for (int q = 0; q < NR; ++q) {
        if (XIN16) { const u32x2* xr = (const u32x2*)((const bf16_t*)xin + (size_t)(row + q * rstride) * DM) + lane;
#pragma unroll
            for (int j = 0; j < 4; ++j) xv[q][j] = unpack4(xr[64 * j]); }
        else { const f32x4* xr = (const f32x4*)(xin + (size_t)(row + q * rstride) * DM) + lane;
#pragma unroll
            for (int j = 0; j < 4; ++j) xv[q][j] = xr[64 * j]; } }
    if (y) {
#pragma unroll
        for (int q = 0; q < NR; ++q) { const u32x2* yr = (const u32x2*)(y + (size_t)(row + q * rstride) * DM) + lane;
#pragma unroll
            for (int j = 0; j < 4; ++j) yv[q][j] = unpack4(yr[64 * j]); }
        f32x4 g[4], gy[4];
#pragma unroll
        for (int j = 0; j < 4; ++j) { g[j] = ((const f32x4*)gate)[lane + 64 * j]; gy[j] = ((const f32x4*)gainY)[lane + 64 * j]; }
        float ss[NR];
#pragma unroll
        for (int q = 0; q < NR; ++q) { ss[q] = 0.f;
#pragma unroll
            for (int j = 0; j < 4; ++j) ss[q] += (yv[q][j][0] * yv[q][j][0] + yv[q][j][1] * yv[q][j][1]) + (yv[q][j][2] * yv[q][j][2] + yv[q][j][3] * yv[q][j][3]); }
#pragma unroll
        for (int o = 1; o < 64; o <<= 1) {
#pragma unroll
            for (int q = 0; q < NR; ++q) ss[q] += __shfl_xor(ss[q], o); }
#pragma unroll
        for (int q = 0; q < NR; ++q) { const float rstd = rsqrtf(ss[q] * (1.f / DM) + EPS);
            if (XOUT16) { u32x2* xo = (u32x2*)((bf16_t*)xout + (size_t)(row + q * rstride) * DM) + lane;
#pragma unroll
                for (int j = 0; j < 4; ++j) { xv[q][j] = xv[q][j] + g[j] * (yv[q][j] * rstd * gy[j]); xo[64 * j] = pack4(xv[q][j]); xv[q][j] = unpack4(pack4(xv[q][j])); } }
            else { f32x4* xo = (f32x4*)(xout + (size_t)(row + q * rstride) * DM) + lane;
#pragma unroll
                for (int j = 0; j < 4; ++j) { xv[q][j] = xv[q][j] + g[j] * (yv[q][j] * rstd * gy[j]); xo[64 * j] = xv[q][j]; } } }
    }
    if (hout) {
        f32x4 gh[4], s1[4], s0[4];
#pragma unroll
        for (int j = 0; j < 4; ++j) { gh[j] = ((const f32x4*)gainH)[lane + 64 * j]; s1[j] = ((const f32x4*)sc)[lane + 64 * j]; s0[j] = ((const f32x4*)sh)[lane + 64 * j]; }
        float ss[NR];
#pragma unroll
        for (int q = 0; q < NR; ++q) { ss[q] = 0.f;
#pragma unroll
            for (int j = 0; j < 4; ++j) ss[q] += (xv[q][j][0] * xv[q][j][0] + xv[q][j][1] * xv[q][j][1]) + (xv[q][j][2] * xv[q][j][2] + xv[q][j][3] * xv[q][j][3]); }
#pragma unroll
        for (int o = 1; o < 64; o <<= 1) {
#pragma unroll
            for (int q = 0; q < NR; ++q) ss[q] += __shfl_xor(ss[q], o); }
#pragma unroll
        for (int q = 0; q < NR; ++q) { const float rstd = rsqrtf(ss[q] * (1.f / DM) + EPS);
            u32x2* ho = (u32x2*)(hout + (size_t)(row + q * rstride) * DM) + lane;
#pragma unroll
            for (int j = 0; j < 4; ++j) { const f32x4 hv = (xv[q][j] * rstd * gh[j]) * (1.f + s1[j]) + s0[j]; ho[64 * j] = pack4(hv); } }
    }
}

__device__ __forceinline__ int t5_bucket(int rel) {
    const int n = rel < 0 ? -rel : rel;
    int v;
    if (n < 8) v = n; else { int lg = 8 + (int)(__builtin_amdgcn_logf((float)n * 0.125f) * (8.f / 7.f)); v = lg < 15 ? lg : 15; }
    return (rel > 0 ? 16 : 0) + v;
}


#define XB_TMO      128
#define XB_XCNT(j)  (256  + 64 * (j))
#define XB_XSUB(j)  (1280 + 64 * (j))
#define XB_XGEN(j)  (2304 + 64 * (j))
#define XB_TOP      3328
#define XB_TOPGEN   3392
#define XCD_BAR_WORDS 3456
#define XB_SPIN_CAP (1u << 22)
__device__ __forceinline__ unsigned xb_ld(unsigned* p)              { return __hip_atomic_load(p, __ATOMIC_RELAXED, __HIP_MEMORY_SCOPE_AGENT); }
__device__ __forceinline__ unsigned xb_add(unsigned* p, unsigned v) { return __hip_atomic_fetch_add(p, v, __ATOMIC_RELAXED, __HIP_MEMORY_SCOPE_AGENT); }
__device__ __forceinline__ unsigned xb_xcc_id() { return (unsigned)__builtin_amdgcn_s_getreg((3 << 11) | 20) & 0xFu; }
#define XB_SPIN(cond, bar) do { unsigned _sp = 0; while (cond) { __builtin_amdgcn_s_sleep(1); \
    if ((++_sp & 255u) == 0u) { if (xb_ld(&(bar)[XB_TMO])) break; if (_sp > XB_SPIN_CAP) { atomicAdd(&(bar)[XB_TMO], 1u); break; } } } } while (0)
__device__ __forceinline__ void xcd_barrier_complete(unsigned* bar, unsigned x, unsigned& nloc, unsigned& nx) {
    const unsigned G = gridDim.x;
    unsigned sum, cnt, mine, sp = 0u;
    for (;;) {
        sum = 0u; cnt = 0u; mine = 0u;
#pragma unroll
        for (unsigned j = 0; j < 16; ++j) { const unsigned c = xb_ld(&bar[XB_XCNT(j)]); sum += c; cnt += (c > 0u) ? 1u : 0u; mine = (j == x) ? c : mine; }
        if (sum == G) break;
        __builtin_amdgcn_s_sleep(1);
        if ((++sp & 255u) == 0u) { if (xb_ld(&bar[XB_TMO])) break; if (sp > XB_SPIN_CAP) { atomicAdd(&bar[XB_TMO], 1u); break; } }
    }
    nloc = mine > 0u ? mine : 1u; nx = cnt > 0u ? cnt : 1u;
}
__device__ __forceinline__ void xcd_barrier(unsigned* bar, volatile LAS unsigned* st) {
    asm volatile("s_waitcnt vmcnt(0)" ::: "memory");
    __syncthreads();
    if (threadIdx.x == 0) {
        __builtin_amdgcn_s_waitcnt(0);
        const unsigned x = xb_xcc_id();
        unsigned nloc = st[0], nx = st[1];
        if (nloc == 0u) { xcd_barrier_complete(bar, x, nloc, nx); st[0] = nloc; st[1] = nx; }
        const unsigned old = xb_add(&bar[XB_XSUB(x)], 1u);
        const unsigned gen = old / nloc;
        if (old + 1u == (gen + 1u) * nloc) {
            __builtin_amdgcn_fence(__ATOMIC_RELEASE, "agent");
            asm volatile("s_waitcnt vmcnt(0)" ::: "memory");
            const unsigned og = xb_add(&bar[XB_TOP], 1u);
            const unsigned tg = og / nx;
            if (og + 1u == (tg + 1u) * nx) xb_add(&bar[XB_TOPGEN], 1u);
            else XB_SPIN(xb_ld(&bar[XB_TOPGEN]) == tg, bar);
            __builtin_amdgcn_fence(__ATOMIC_ACQUIRE, "agent");
            xb_add(&bar[XB_XGEN(x)], 1u);
            asm volatile("s_waitcnt vmcnt(0)" ::: "memory");
        } else {
            XB_SPIN(xb_ld(&bar[XB_XGEN(x)]) == gen, bar);
            __builtin_amdgcn_fence(__ATOMIC_ACQUIRE, "agent");
            asm volatile("s_waitcnt vmcnt(0)" ::: "memory");
        }
    }
    __syncthreads();
}
typedef const __attribute__((address_space(4))) Args* CArgsP;
__device__ __forceinline__ CArgsP largs() { CArgsP p = (CArgsP)__builtin_amdgcn_kernarg_segment_ptr(); asm volatile("" : "+s"(p)); return p; }
__device__ __forceinline__ int otid() { int t = threadIdx.x; asm volatile("" : "+v"(t)); return t; }
__global__ void __launch_bounds__(NTHREADS) mega(Args a) {
    extern __shared__ __attribute__((aligned(16))) unsigned char lds_raw[];
    LAS unsigned char* lds = (LAS unsigned char*)lds_raw;
    cg::grid_group grid = cg::this_grid();
    volatile LAS unsigned* bst = (volatile LAS unsigned*)(lds + 131072);
    if (threadIdx.x < 2) bst[threadIdx.x] = 0u;
    __syncthreads();
    if (gridDim.x == 0x7fffffffu) grid.sync();
    { CArgsP ap0 = largs(); unsigned* bar0 = (unsigned*)ap0->ws; if (threadIdx.x == 0) (void)xb_add(&bar0[XB_XCNT(xb_xcc_id())], 1u); }
#define GSYNC() do { CArgsP apb_ = largs(); xcd_barrier((unsigned*)apb_->ws, bst); } while (0)
    const int G = gridDim.x, bid = blockIdx.x;
    const int NGW = G * NWAVES, NGT = G * NTHREADS;
#define PHASE_IDS() const int tid = otid(), lane = tid & 63, wave = __builtin_amdgcn_readfirstlane(tid >> 6); const int gw = bid * NWAVES + wave; const int gt = bid * NTHREADS + tid; (void)gw; (void)gt; (void)lane; PTRS()
#define PTRS() CArgsP ap_ = largs(); unsigned char* ws = ap_->ws; const float* x_in = (const float*)ap_->in[0]; const float* c_in = (const float*)ap_->in[1]; const int* positions = (const int*)ap_->in[2]; const float* rel_bias = (const float*)ap_->in[3]; const float* w_mod = (const float*)ap_->in[4]; const float* b_mod = (const float*)ap_->in[5]; const float* norm_g = (const float*)ap_->in[6]; const float* a_sink = (const float*)ap_->in[8]; const float* b_conv = (const float*)ap_->in[9]; const float* c_norm_q = (const float*)ap_->in[10]; const float* c_norm_kv = (const float*)ap_->in[11]; const float* ffn_conv = (const float*)ap_->in[16]; float* MOD = (float*)(ws + WS_MOD); float* CS = (float*)(ws + WS_CS); float* LUTA = (float*)(ws + WS_LUT); float* LUTD = LUTA + 4 * 257; bf16_t* HB = (bf16_t*)(ws + WS_HB); bf16_t* PROJ = (bf16_t*)(ws + WS_PROJ); bf16_t* UB = (bf16_t*)(ws + WS_PROJ); bf16_t* ACT = (bf16_t*)(ws + WS_ACT); bf16_t* MIX = (bf16_t*)(ws + WS_MIX); bf16_t* DPART = (bf16_t*)(ws + WS_DPART); bf16_t* KR = (bf16_t*)(ws + WS_KR); float* LSEB = (float*)(ws + WS_LSE); float* xout = ap_->out; (void)ws; (void)x_in; (void)c_in; (void)positions; (void)rel_bias; (void)w_mod; (void)b_mod; (void)norm_g; (void)a_sink; (void)b_conv; (void)c_norm_q; (void)c_norm_kv; (void)ffn_conv; (void)MOD; (void)CS; (void)LUTA; (void)LUTD; (void)HB; (void)PROJ; (void)UB; (void)ACT; (void)MIX; (void)DPART; (void)KR; (void)LSEB; (void)xout

    { PHASE_IDS();
    LAS float* sl = (LAS float*)(lds + 65536);
    for (int i = tid; i < 8 * 1024; i += NTHREADS) { const float cv = c_in[i]; sl[i] = cv * __builtin_amdgcn_rcpf(1.f + __builtin_amdgcn_exp2f(-cv * LOG2E)); }
    __syncthreads();
    for (int it = gw; it < DEPTH * 24 * 16; it += NGW) {
        const int l = it / 384, rem = it % 384, cb = rem >> 4, kc = rem & 15;
        const int col = cb * 256 + 4 * lane;
        const float* w = w_mod + ((size_t)l * 1024 + kc * 64) * 6144 + col;
        f32x4 acc[8];
#pragma unroll
        for (int b = 0; b < 8; ++b) acc[b] = (f32x4){0.f, 0.f, 0.f, 0.f};
        for (int k0 = 0; k0 < 64; k0 += 8) {
            f32x4 wv[8];
#pragma unroll
            for (int k = 0; k < 8; ++k) wv[k] = *(const f32x4*)(w + (size_t)(k0 + k) * 6144);
#pragma unroll
            for (int k = 0; k < 8; ++k)
#pragma unroll
                for (int b = 0; b < 8; ++b) acc[b] += wv[k] * sl[b * 1024 + kc * 64 + k0 + k];
        }
        float* MP = (float*)(ws + WS_ACT);
#pragma unroll
        for (int b = 0; b < 8; ++b) *(f32x4*)(MP + (((size_t)l * 16 + kc) * 8 + b) * 6144 + col) = acc[b];
    }
    __syncthreads();
    convert_weights((const float*)ap_->in[7], (const float*)ap_->in[12], (const float*)ap_->in[13], (const float*)ap_->in[14], (const float*)ap_->in[15], (const float*)ap_->in[17], ws, 0, lds, gw, NGW, wave, lane);
    for (int i = gt; i < T * 16; i += NGT) {
        const int row = i >> 4, j = i & 15;
        const float invf = __builtin_amdgcn_exp2f(-(float)j * (13.287712379549449f / 16.f));
        const float ang = (float)positions[row] * invf;
        const double rev = (double)ang * 0.15915494309189535;
        const float fr = (float)(rev - __builtin_rint(rev));
        CS[(size_t)row * 32 + j] = __builtin_amdgcn_cosf(fr);
        CS[(size_t)row * 32 + 16 + j] = __builtin_amdgcn_sinf(fr);
    }
    if (bid == 0) {
        for (int i = tid; i < 4 * 257; i += NTHREADS) { const int hd = i / 257, rel = i % 257 - 128; LUTA[i] = rel_bias[t5_bucket(rel) * 16 + hd] * LOG2E; }
        for (int i = tid; i < 12 * 129; i += NTHREADS) { const int gh = i / 129, ri = i % 129 - 64, g = gh >> 2, hd = gh & 3; const int d = (g == 0) ? 1 : (g == 1 ? 4 : 16);
            LUTD[i] = rel_bias[t5_bucket(ri * d) * 16 + 4 + 4 * g + hd] * LOG2E; }
    }
    }
    GSYNC();
    { PHASE_IDS(); const float* MP = (const float*)(ws + WS_ACT);
      for (int i = gt; i < DEPTH * 8 * 6144; i += NGT) { const int l = i / (8 * 6144), rem = i % (8 * 6144), b = rem / 6144, col = rem % 6144;
          float s = b_mod[l * 6144 + col];
#pragma unroll
          for (int kc = 0; kc < 16; ++kc) s += MP[(((size_t)l * 16 + kc) * 8 + b) * 6144 + col];
          MOD[i] = s; } }
    GSYNC();
    { PHASE_IDS();
    for (int row = 2 * gw; row < T; row += 2 * NGW) {
        const int b = row >> 12; const float* md = MOD + (size_t)b * 6144;
        row_pass<2>(row, 1, x_in, nullptr, nullptr, nullptr, nullptr, norm_g, md + 1024, md, HB, lane);
    } }
    GSYNC();

    for (int l = 0; l < DEPTH; ++l) {
        { PTRS(); pg8::Gemm g{HB, (const bf16_t*)(ws + W_IN), T, NIN, 1024, 1024}; pg8::StaticOrder S; S.init(T, NIN, G, bid);
          pg8::EpiProj E{PROJ}; pg8::gemm_phase<pg8::EpiProj, true>(lds, g, S, E); }
        GSYNC();
        { PHASE_IDS();
        const f32x4 gq = ((const f32x4*)(c_norm_q + l * 256))[lane];
        const f32x2 gk = ((const f32x2*)(c_norm_kv + l * 128))[lane];
        const float* bw = b_conv + (size_t)l * 3 * 256;
        const f32x4 w0 = ((const f32x4*)bw)[lane], w1 = ((const f32x4*)(bw + 256))[lane], w2 = ((const f32x4*)(bw + 512))[lane];
        for (int row0 = 4 * gw; row0 < T; row0 += 4 * NGW) {
            bf16_t* pr = PROJ + (size_t)row0 * PRM;
            const int s0 = row0 & (SEQ - 1);
            u32x2 cqw[4]; unsigned ckw[4]; u32x2 bbw[4]; u32x2 bcw[6], bhw[6];
#pragma unroll
            for (int q = 0; q < 4; ++q) { cqw[q] = ((const u32x2*)(pr + (size_t)q * PRM + 768))[lane]; ckw[q] = ((const unsigned*)(pr + (size_t)q * PRM + 1024))[lane];
                bbw[q] = ((const u32x2*)(pr + (size_t)q * PRM + 0))[lane]; }
#pragma unroll
            for (int k = 0; k < 6; ++k) { const bool ok = (k == 0) ? (s0 > 0) : ((k == 5) ? (s0 + 4 < SEQ) : true);
                bcw[k] = (u32x2){0u, 0u}; bhw[k] = bcw[k];
                if (ok) { bcw[k] = ((const u32x2*)(pr + (ptrdiff_t)(k - 1) * PRM + 256))[lane]; bhw[k] = ((const u32x2*)(pr + (ptrdiff_t)(k - 1) * PRM + 512))[lane]; } }
            const int rq = lane >> 4, ri = lane & 15;
            const float t1 = bf1(pr[(size_t)rq * PRM + 1152 + ri]), t2 = bf1(pr[(size_t)rq * PRM + 1168 + ri]);
            const float cs_ = CS[(size_t)(row0 + rq) * 32 + ri], sn = CS[(size_t)(row0 + rq) * 32 + 16 + ri];
            f32x4 cqv[4]; float kv0[4], kv1[4], ssq[4], ssk[4];
#pragma unroll
            for (int q = 0; q < 4; ++q) { cqv[q] = unpack4(cqw[q]); kv0[q] = bf_lo(ckw[q]); kv1[q] = bf_hi(ckw[q]);
                ssq[q] = (cqv[q][0] * cqv[q][0] + cqv[q][1] * cqv[q][1]) + (cqv[q][2] * cqv[q][2] + cqv[q][3] * cqv[q][3]); ssk[q] = kv0[q] * kv0[q] + kv1[q] * kv1[q]; }
#pragma unroll
            for (int o = 1; o < 64; o <<= 1) {
#pragma unroll
                for (int q = 0; q < 4; ++q) { ssq[q] += __shfl_xor(ssq[q], o); ssk[q] += __shfl_xor(ssk[q], o); } }
#pragma unroll
            for (int q = 0; q < 4; ++q) {
                const float rq_ = rsqrtf(ssq[q] * (1.f / 256.f) + EPS), rk_ = rsqrtf(ssk[q] * (1.f / 128.f) + EPS);
                ((u32x2*)(pr + (size_t)q * PRM + 768))[lane] = pack4(cqv[q] * rq_ * gq);
                ((unsigned*)(pr + (size_t)q * PRM + 1024))[lane] = pk2(kv0[q] * rk_ * gk[0], kv1[q] * rk_ * gk[1]);
            }
            KR[(size_t)(row0 + rq) * 32 + ri] = (bf16_t)(pk2(t1 * cs_ - t2 * sn, 0.f) & 0xffffu);
            KR[(size_t)(row0 + rq) * 32 + 16 + ri] = (bf16_t)(pk2(t2 * cs_ + t1 * sn, 0.f) & 0xffffu);
            f32x4 prod[6];
#pragma unroll
            for (int k = 0; k < 6; ++k) prod[k] = unpack4(bcw[k]) * unpack4(bhw[k]);
#pragma unroll
            for (int q = 0; q < 4; ++q) { const f32x4 ob = unpack4(bbw[q]) * (prod[q] * w0 + prod[q + 1] * w1 + prod[q + 2] * w2);
                ((u32x2*)(MIX + (size_t)(row0 + q) * 1024 + 256))[lane] = pack4(ob); }
        } }
        GSYNC();
        { PTRS(); pg8::Gemm g{PROJ + 768, (const bf16_t*)(ws + W_MLA), T, 1024, 384, PRM}; pg8::StaticOrder S; S.init(T, 1024, G, bid);
          pg8::EpiMla E{HB, 1024, CS, 0.10206207261596575f * LOG2E}; pg8::gemm_phase<pg8::EpiMla, true>(lds, g, S, E); }
        GSYNC();
        { PHASE_IDS();
        if (wave >= 4) __builtin_amdgcn_s_setprio(1);
        for (int ui = bid; ui < 5 * 512; ui += G) {
            const int kind = ui >> 9, idx = ui & 511;
            const int bb = idx >> 6, rem = idx & 63, head = rem >> 4, rr = rem & 15;
            AU u;
            if (kind == 0) {
                const size_t hrow = (size_t)(bb * 4 + head) * SEQ;
                u.Q = HB + hrow * 96; u.qpitch = 96; u.K1 = HB + (size_t)T * 384 + hrow * 64; u.k1pitch = 64; u.K2 = KR + (size_t)bb * SEQ * 32; u.k2pitch = 32;
                u.V = HB + (size_t)T * 640 + hrow * 64; u.vpitch = 64; u.O = MIX + (size_t)bb * SEQ * 1024 + 512 + head * 64; u.opitch = 1024; u.LSE = nullptr; u.lsepitch = 0; u.lut = nullptr;
                u.R = 1 << 20; u.q0 = 256 * rr; u.kt_lo = 0; u.kt_hi = 64; u.sc = 0.10206207261596575f * LOG2E; u.m0 = -1e30f; u.l0 = 0.f;
                attn_unit_c(lds, u, tid, wave, lane);
            } else {
                int Ls;
                if (kind == 1) {
                    const bf16_t* hmb = PROJ + HM_OFF;
                    u.Q = hmb + ((size_t)(bb * 4 + head) * SEQ) * 64; u.qpitch = 64;
                    u.K1 = hmb + (size_t)T * 256 + ((size_t)(bb * 4 + (head >> 1)) * SEQ) * 64; u.k1pitch = 64;
                    u.V = hmb + (size_t)T * 256 + ((size_t)(bb * 4 + 2 + (head >> 1)) * SEQ) * 64; u.vpitch = 64;
                    u.O = MIX + (size_t)bb * SEQ * 1024 + head * 64; u.opitch = 1024; u.LSE = nullptr; u.lsepitch = 0; u.lut = LUTA + head * 257;
                    u.R = 128; u.q0 = 256 * rr; Ls = SEQ; u.m0 = a_sink[l * 4 + head] * LOG2E; u.l0 = 1.f;
                } else {
                    const int g = kind - 2, d = (g == 0) ? 1 : (g == 1 ? 4 : 16);
                    const int res = rr % d, qb = rr / d; Ls = SEQ / d;
                    const size_t brow = (size_t)bb * SEQ + res;
                    { const bf16_t* hmb = PROJ + HM_OFF; const size_t hoff = ((size_t)(bb * 4 + head) * SEQ + (size_t)res * Ls) * 64;
                      u.Q = hmb + (size_t)(2 + 3 * g) * T * 256 + hoff; u.K1 = hmb + (size_t)(3 + 3 * g) * T * 256 + hoff; u.V = hmb + (size_t)(4 + 3 * g) * T * 256 + hoff;
                      u.qpitch = 64; u.k1pitch = 64; u.vpitch = 64; }
                    u.O = DPART + (size_t)g * T * 256 + brow * 256 + head * 64; u.opitch = d * 256; u.LSE = LSEB + (size_t)g * T * 4 + brow * 4 + head; u.lsepitch = 4 * d;
                    u.lut = LUTD + (g * 4 + head) * 129; u.R = 64; u.q0 = 256 * qb; u.m0 = -1e30f; u.l0 = 0.f;
                }
                u.K2 = nullptr; u.k2pitch = 0; u.sc = 0.125f * LOG2E;
                const int lo = (u.q0 - u.R) >> 6, hi = ((u.q0 + 255 + u.R) >> 6) + 1;
                u.kt_lo = lo < 0 ? 0 : lo; u.kt_hi = hi > (Ls >> 6) ? (Ls >> 6) : hi;
                attn_unit_w(lds, u, tid, wave, lane);
            }
        }
        __builtin_amdgcn_s_setprio(0); }
        GSYNC();
        { PHASE_IDS();
        const int hd = lane >> 4;
        for (int row0 = 4 * gw; row0 < T; row0 += 4 * NGW) {
            float lse[4][3]; u32x2 dv[4][3];
#pragma unroll
            for (int q = 0; q < 4; ++q)
#pragma unroll
                for (int g = 0; g < 3; ++g) { lse[q][g] = LSEB[(size_t)g * T * 4 + (size_t)(row0 + q) * 4 + hd]; dv[q][g] = ((const u32x2*)(DPART + (size_t)g * T * 256 + (size_t)(row0 + q) * 256))[lane]; }
#pragma unroll
            for (int q = 0; q < 4; ++q) {
                const float mx = fmaxf(lse[q][0], fmaxf(lse[q][1], lse[q][2]));
                const float e0 = __builtin_amdgcn_exp2f(lse[q][0] - mx), e1 = __builtin_amdgcn_exp2f(lse[q][1] - mx), e2 = __builtin_amdgcn_exp2f(lse[q][2] - mx);
                const float inv = 1.f / (e0 + e1 + e2);
                const f32x4 od = (unpack4(dv[q][0]) * e0 + unpack4(dv[q][1]) * e1 + unpack4(dv[q][2]) * e2) * inv;
                ((u32x2*)(MIX + (size_t)(row0 + q) * 1024 + 768))[lane] = pack4(od);
            }
        } }
        GSYNC();
        { PTRS(); pg8::Gemm g{MIX, (const bf16_t*)(ws + W_OUT), T, 1024, 1024, 1024}; pg8::StaticOrder S; S.init(T, 1024, G, bid);
          pg8::EpiBf16 E{HB, 1024}; pg8::gemm_phase<pg8::EpiBf16, true>(lds, g, S, E); }
        GSYNC();
        { PHASE_IDS(); const float* MODl = MOD + (size_t)l * 8 * 6144; const float* ng = norm_g + (size_t)l * 4 * 1024;
        for (int row = 4 * gw; row < T; row += 4 * NGW) {
            const int b = row >> 12; const float* md = MODl + (size_t)b * 6144;
            if (l == 0) row_pass<4, false, true>(row, 1, x_in, HB, md + 2048, ng + 1024, (float*)(ws + WS_PROJ + 16 * MiB), ng + 2048, md + 4096, md + 3072, HB, lane);
            else row_pass<4, true, true>(row, 1, (const float*)((const bf16_t*)xout + (size_t)T * DM), HB, md + 2048, ng + 1024, (float*)(ws + WS_PROJ + 16 * MiB), ng + 2048, md + 4096, md + 3072, HB, lane);
        } }
        GSYNC();
        { PTRS(); pg8::Gemm g{HB, (const bf16_t*)(ws + W_UP), T, 2 * DFF, 1024, 1024}; pg8::StaticOrder S; S.init(T, 2 * DFF, G, bid);
          pg8::EpiConv E{ACT, (float*)(ws + WS_PROJ), ffn_conv + (size_t)l * 3 * 5632}; pg8::gemm_phase<pg8::EpiConv, true>(lds, g, S, E); }
        GSYNC();
        { PHASE_IDS();
          pg8::StaticOrder S; S.init(T, 1024, G, bid); pg8::Unit uu;
          const float* UH = (const float*)(ws + WS_PROJ);
          const float* fw = ffn_conv + (size_t)l * 3 * 5632;
          for (int i = 0; S.next(i, uu); ++i) {
              const int pm = uu.pm;
              if (tid < 352) {
                  const int c = 8 * tid, tile = c >> 7, within = c & 127, gcol = 256 * tile + within;
                  float wg[3][8], wv[3][8];
#pragma unroll
                  for (int t3 = 0; t3 < 3; ++t3) { const f32x4 a0 = *(const f32x4*)(fw + t3 * 5632 + c), a1 = *(const f32x4*)(fw + t3 * 5632 + c + 4);
                      const f32x4 b0 = *(const f32x4*)(fw + t3 * 5632 + 2816 + c), b1 = *(const f32x4*)(fw + t3 * 5632 + 2816 + c + 4);
#pragma unroll
                      for (int e = 0; e < 4; ++e) { wg[t3][e] = a0[e]; wg[t3][4 + e] = a1[e]; wv[t3][e] = b0[e]; wv[t3][4 + e] = b1[e]; } }
#pragma unroll
                  for (int which = 0; which < 2; ++which) {
                      const int row = 256 * pm + (which ? 255 : 0), s = row & (SEQ - 1);
                      const float* up_p = which ? UH + ((size_t)pm * 4 + 2) * 5632 : UH + ((size_t)(pm - 1) * 4 + 3) * 5632;
                      const bool up_ok = which ? true : (s != 0);
                      const float* cur_p = UH + ((size_t)pm * 4 + (which ? 3 : 0)) * 5632;
                      const float* dn_p = which ? UH + ((size_t)(pm + 1) * 4) * 5632 : UH + ((size_t)pm * 4 + 1) * 5632;
                      const bool dn_ok = which ? (s != SEQ - 1) : true;
                      float ug[8], uv[8];
#pragma unroll
                      for (int hf = 0; hf < 2; ++hf) {
                          const f32x4 z = {0.f, 0.f, 0.f, 0.f};
                          const f32x4 gu = up_ok ? *(const f32x4*)(up_p + gcol + 4 * hf) : z, vu = up_ok ? *(const f32x4*)(up_p + gcol + 128 + 4 * hf) : z;
                          const f32x4 gc = *(const f32x4*)(cur_p + gcol + 4 * hf), vc = *(const f32x4*)(cur_p + gcol + 128 + 4 * hf);
                          const f32x4 gd = dn_ok ? *(const f32x4*)(dn_p + gcol + 4 * hf) : z, vd = dn_ok ? *(const f32x4*)(dn_p + gcol + 128 + 4 * hf) : z;
#pragma unroll
                          for (int e = 0; e < 4; ++e) { const int k = 4 * hf + e;
                              ug[k] = wg[0][k] * gu[e] + wg[1][k] * gc[e] + wg[2][k] * gd[e];
                              uv[k] = wv[0][k] * vu[e] + wv[1][k] * vc[e] + wv[2][k] * vd[e]; }
                      }
                      u32x4 ow;
#pragma unroll
                      for (int e2 = 0; e2 < 4; ++e2) ow[e2] = pk2(gelu_tanh(ug[2 * e2]) * uv[2 * e2], gelu_tanh(ug[2 * e2 + 1]) * uv[2 * e2 + 1]);
                      *(u32x4*)(ACT + (size_t)row * DFF + c) = ow;
                  }
              }
          }
          asm volatile("s_waitcnt vmcnt(0)" ::: "memory"); __syncthreads();
        }
        { PTRS(); pg8::Gemm g{ACT, (const bf16_t*)(ws + W_DOWN), T, 1024, DFF, DFF}; pg8::StaticOrder S; S.init(T, 1024, G, bid);
          pg8::EpiBf16 E{HB, 1024}; pg8::gemm_phase<pg8::EpiBf16, true>(lds, g, S, E); }
        GSYNC();
        { PHASE_IDS(); const float* MODl = MOD + (size_t)l * 8 * 6144; const float* ng = norm_g + (size_t)l * 4 * 1024;
            const bool lastl = (l == DEPTH - 1);
            const float* MODn = MOD + (size_t)(lastl ? l : l + 1) * 8 * 6144;
            const float* ngn = norm_g + (size_t)(lastl ? l : l + 1) * 4 * 1024;
            for (int row = 4 * gw; row < T; row += 4 * NGW) {
                const int b = row >> 12; const float* md = MODl + (size_t)b * 6144; const float* mdn = MODn + (size_t)b * 6144;
                if (lastl) row_pass<4, true, false>(row, 1, (const float*)(ws + WS_PROJ + 16 * MiB), HB, md + 5120, ng + 3072, xout, ngn, mdn + 1024, mdn, nullptr, lane);
                else row_pass<4, true, true>(row, 1, (const float*)(ws + WS_PROJ + 16 * MiB), HB, md + 5120, ng + 3072, (float*)((bf16_t*)xout + (size_t)T * DM), ngn, mdn + 1024, mdn, HB, lane);
            }
            if (!lastl) convert_weights((const float*)ap_->in[7], (const float*)ap_->in[12], (const float*)ap_->in[13], (const float*)ap_->in[14], (const float*)ap_->in[15], (const float*)ap_->in[17], ws, l + 1, lds, gw, NGW, wave, lane);
        }
        if (l + 1 < DEPTH) GSYNC();
    }
}

extern "C" void kernel_launch(void* const* d_in, const int* in_sizes, int n_in, void* d_out, int out_size, void* d_ws, size_t ws_size, hipStream_t stream) {
    static int grid = 0;
    if (grid == 0) {
        if (n_in != 18 || ws_size < WS_END) { fprintf(stderr, "kernel_launch: unexpected n_in %d / ws_size %zu (need %zu)\n", n_in, ws_size, (size_t)WS_END); grid = -1; return; }
        int dev = 0, cus = 0;
        hipGetDevice(&dev); hipDeviceGetAttribute(&cus, hipDeviceAttributeMultiprocessorCount, dev);
        if (hipFuncSetAttribute((const void*)mega, hipFuncAttributeMaxDynamicSharedMemorySize, LDS_BYTES) != hipSuccess) { fprintf(stderr, "hipFuncSetAttribute failed\n"); grid = -1; return; }
        grid = cus > 0 ? cus : 256;
    }
    if (grid < 0) return;
    hipMemsetAsync(d_ws, 0, XCD_BAR_WORDS * 4, stream);
    Args a{};
    for (int i = 0; i < 18; ++i) a.in[i] = d_in[i];
    a.out = (float*)d_out; a.ws = (unsigned char*)d_ws;
    void* args[] = {&a};
    hipError_t e = hipLaunchCooperativeKernel((const void*)mega, dim3(grid), dim3(NTHREADS), args, LDS_BYTES, stream);
    if (e != hipSuccess) fprintf(stderr, "cooperative launch failed: %s (grid %d)\n", hipGetErrorString(e), grid);
}
```

```cpp
#include <hip/hip_runtime.h>
#include <hip/hip_cooperative_groups.h>
#include <cstdio>
#include <cstdint>
namespace cg = cooperative_groups;

#define LAS __attribute__((address_space(3)))
typedef unsigned short bf16_t;
typedef short bf16x8 __attribute__((ext_vector_type(8)));
typedef short s16x4 __attribute__((ext_vector_type(4)));
typedef float f32x4 __attribute__((ext_vector_type(4)));
typedef float f32x2 __attribute__((ext_vector_type(2)));
typedef float f32x16 __attribute__((ext_vector_type(16)));
typedef unsigned u32x4 __attribute__((ext_vector_type(4)));
typedef unsigned u32x2 __attribute__((ext_vector_type(2)));
typedef __bf16 bf16x2_t __attribute__((ext_vector_type(2)));

constexpr int NB = 8, SEQ = 4096, T = NB * SEQ, DM = 1024, NIN = 4096, DFF = 2816, DEPTH = 4;
constexpr int NTHREADS = 512, NWAVES = 8;
constexpr float EPS = 1e-6f, LOG2E = 1.4426950408889634f;
constexpr int PRM = 1280;
constexpr size_t HM_OFF = (size_t)T * PRM;
constexpr int UP0 = 1536, UP1 = 1280, ULD = 3072;

constexpr size_t MiB = 1u << 20;
constexpr size_t WS_MOD = 1 * MiB;
constexpr size_t MOD_BYTES = (size_t)DEPTH * NB * 6144 * 4;
constexpr size_t WS_CS = 2 * MiB;
constexpr size_t WS_LUT = 6 * MiB;
constexpr size_t WS_W = 8 * MiB;
constexpr size_t W_IN = WS_W, W_MLA = WS_W + 8 * MiB, W_OUT = WS_W + 9 * MiB, W_UP = WS_W + 11 * MiB, W_DOWN = WS_W + 22 * MiB;
constexpr size_t WS_HB = 36 * MiB;
constexpr size_t WS_PROJ = 100 * MiB;
constexpr size_t WS_ACT = 292 * MiB;
constexpr size_t WS_MIX = 356 * MiB;
constexpr size_t WS_DPART = 420 * MiB;
constexpr size_t WS_KR = 468 * MiB;
constexpr size_t WS_LSE = 470 * MiB;
constexpr size_t WS_END = 472 * MiB;

constexpr int LDS_BYTES = 131072 + 1024 + 8192;
constexpr int LDS_XB = 131072 + 1024;

__device__ __forceinline__ unsigned pk2(float lo, float hi) { f32x2 v = {lo, hi}; bf16x2_t b = __builtin_convertvector(v, bf16x2_t); return __builtin_bit_cast(unsigned, b); }
__device__ __forceinline__ float bf_lo(unsigned w) { return __uint_as_float(w << 16); }
__device__ __forceinline__ float bf_hi(unsigned w) { return __uint_as_float(w & 0xffff0000u); }
__device__ __forceinline__ float bf1(bf16_t w) { return __uint_as_float(((unsigned)w) << 16); }
__device__ __forceinline__ float wave_sum(float v) {
#pragma unroll
    for (int o = 1; o < 64; o <<= 1) v += __shfl_xor(v, o);
    return v;
}
__device__ __forceinline__ float max3f(float a, float b, float c) { float r; asm("v_max3_f32 %0, %1, %2, %3" : "=v"(r) : "v"(a), "v"(b), "v"(c)); return r; }
__device__ __forceinline__ float max2f(float a, float b) { float r; asm("v_max_f32_e32 %0, %1, %2" : "=v"(r) : "v"(a), "v"(b)); return r; }
__device__ __forceinline__ f32x4 unpack4(u32x2 w) { return (f32x4){bf_lo(w.x), bf_hi(w.x), bf_lo(w.y), bf_hi(w.y)}; }
__device__ __forceinline__ u32x2 pack4(f32x4 v) { u32x2 w; w.x = pk2(v[0], v[1]); w.y = pk2(v[2], v[3]); return w; }

__device__ __forceinline__ float gelu_tanh(float x) {
    const float t = x + 0.044715f * x * x * x;
    const float e = __builtin_amdgcn_exp2f(-2.f * 0.7978845608028654f * LOG2E * t);
    return x * __builtin_amdgcn_rcpf(1.f + e);
}
namespace pg8 {
constexpr int BM = 256, BK = 64, HALF = 128, HTB = HALF * BK * 2, STAGE_BYTES = 8 * HTB, NXCD = 8, WGM = 8;
__host__ __device__ __forceinline__ int lds_byte(int r, int c) { const int st = (r >> 4) * 2 + (c >> 5), rr = r & 15, cc = c & 31, ob = rr * 64 + cc * 2; return st * 1024 + (ob ^ (((ob >> 9) & 1) << 5)); }
__host__ __device__ __forceinline__ void stage_rc(int b, int& R, int& C) { const int st = b / 1024, sb = b % 1024, swz = sb ^ (((sb >> 9) & 1) << 5); R = (st >> 1) * 16 + swz / 64; C = (st & 1) * 32 + (swz % 64) / 2; }
__host__ __device__ __forceinline__ int perm32(int rho) { const int n = rho >> 4, i = rho & 15; return 8 * (i >> 2) + 4 * n + (i & 3); }

struct Unit { int pm, pn; };
struct Gemm { const bf16_t* A; const bf16_t* Bt; int M, N, K, lda; };

struct StaticOrder {
    int nM, nN, nwg, G, c;
    __device__ __forceinline__ void init(int M, int N, int G_, int c_) { nM = M / BM; nN = N / BM; nwg = nM * nN; G = G_; c = c_; }
    __device__ __forceinline__ bool next(int i, Unit& u) const {
        const long L = (long)i * G + c; if (L >= nwg) return false;
        int wgid = (int)L; { const int q = nwg / NXCD, r = nwg % NXCD, xcd = wgid % NXCD, off = wgid / NXCD; wgid = (xcd < r ? xcd * (q + 1) : r * (q + 1) + (xcd - r) * q) + off; }
        const int nig = WGM * nN, gid = wgid / nig, fm = gid * WGM, gsz = (nM - fm) < WGM ? (nM - fm) : WGM;
        u.pm = fm + ((wgid % nig) % gsz); u.pn = (wgid % nig) / gsz; return true;
    }
};

struct EpiBf16 {
    static constexpr bool PERM = true, NEEDS_LDS = false;
    bf16_t* O; int ldc;
    __device__ __forceinline__ void operator()(const f32x4 (&acc)[2][2][4][2], const Unit& u, int wr, int wc, int fr, int fq) const {
        const int row0 = u.pm * BM + wr * 64 + fr; const int col0 = u.pn * BM + wc * 32 + 8 * fq;
#pragma unroll
        for (int ai = 0; ai < 2; ++ai)
#pragma unroll
            for (int m = 0; m < 4; ++m) { bf16_t* rowp = O + (size_t)(row0 + ai * HALF + m * 16) * ldc + col0;
#pragma unroll
                for (int bj = 0; bj < 2; ++bj) { const f32x4 v0 = acc[ai][bj][m][0], v1 = acc[ai][bj][m][1];
                    u32x4 w; w.x = pk2(v0[0], v0[1]); w.y = pk2(v0[2], v0[3]); w.z = pk2(v1[0], v1[1]); w.w = pk2(v1[2], v1[3]);
                    *(u32x4*)(rowp + bj * HALF) = w; } }
    }
};
struct EpiProj {
    static constexpr bool PERM = true, NEEDS_LDS = false;
    bf16_t* O;
    __device__ __forceinline__ void operator()(const f32x4 (&acc)[2][2][4][2], const Unit& u, int wr, int wc, int fr, int fq) const {
        const int row0 = u.pm * BM + wr * 64 + fr; const int pn = u.pn;
        const bool rm = (pn >= 2 && pn <= 6);
        const int hm = pn < 2 ? pn : pn - 5;
        const int gsel = pn < 7 ? 0 : (pn - 7) / 3;
        const int dsh = gsel == 0 ? 0 : (gsel == 1 ? 2 : 4);
#pragma unroll
        for (int ai = 0; ai < 2; ++ai)
#pragma unroll
            for (int m = 0; m < 4; ++m) {
                const int row = row0 + ai * HALF + m * 16;
                const int b = row >> 12, s = row & (SEQ - 1);
                const int sp = ((s & ((1 << dsh) - 1)) << (12 - dsh)) + (s >> dsh);
#pragma unroll
                for (int bj = 0; bj < 2; ++bj) { const f32x4 v0 = acc[ai][bj][m][0], v1 = acc[ai][bj][m][1];
                    u32x4 w; w.x = pk2(v0[0], v0[1]); w.y = pk2(v0[2], v0[3]); w.z = pk2(v1[0], v1[1]); w.w = pk2(v1[2], v1[3]);
                    const int c = bj * HALF + wc * 32 + 8 * fq;
                    bf16_t* dst = rm ? O + (size_t)row * PRM + (pn - 2) * 256 + c
                                     : O + HM_OFF + (size_t)hm * T * 256 + ((size_t)(b * 4 + (c >> 6)) * SEQ + sp) * 64 + (c & 63);
                    *(u32x4*)dst = w; }
            }
    }
};
struct EpiMla {
    static constexpr bool PERM = false, NEEDS_LDS = false;
    bf16_t* O; int ldc; const float* cs; float qs;
    __device__ __forceinline__ void operator()(const f32x4 (&acc)[2][2][4][2], const Unit& u, int wr, int wc, int fr, int fq) const {
        const int row0 = u.pm * BM + wr * 64 + fr;
#pragma unroll
        for (int bj = 0; bj < 2; ++bj) {
            const int cgp = u.pn * 8 + bj * 4 + wc;
            const bool rope = (cgp < 12) && ((cgp % 3) == 2);
            const int col0 = cgp * 32 + 4 * fq;
#pragma unroll
            for (int ai = 0; ai < 2; ++ai)
#pragma unroll
                for (int m = 0; m < 4; ++m) {
                    const int row = row0 + ai * HALF + m * 16;
                    f32x4 v0 = acc[ai][bj][m][0], v1 = acc[ai][bj][m][1];
                    if (rope) {
                        const f32x4 c = *(const f32x4*)(cs + (size_t)row * 32 + 4 * fq), s = *(const f32x4*)(cs + (size_t)row * 32 + 16 + 4 * fq);
                        const f32x4 a = v0 * c - v1 * s, b = v1 * c + v0 * s; v0 = a; v1 = b;
                    }
                    if (cgp < 12) { v0 = v0 * qs; v1 = v1 * qs; }
                    const int bq = row >> 12, sq = row & (SEQ - 1);
                    bf16_t* rowp;
                    if (cgp < 12) rowp = O + ((size_t)(bq * 4 + cgp / 3) * SEQ + sq) * 96 + (cgp % 3) * 32 + 4 * fq;
                    else if (cgp < 20) rowp = O + (size_t)T * 384 + ((size_t)(bq * 4 + (cgp - 12) / 2) * SEQ + sq) * 64 + ((cgp - 12) & 1) * 32 + 4 * fq;
                    else rowp = O + (size_t)T * 640 + ((size_t)(bq * 4 + (cgp - 20) / 2) * SEQ + sq) * 64 + ((cgp - 20) & 1) * 32 + 4 * fq;
                    if (cgp < 28) { *(u32x2*)(rowp) = pack4(v0); *(u32x2*)(rowp + 16) = pack4(v1); }
                }
        }
    }
};

#define DPP_ROR1 0x121
#define DPP_ROR15 0x12F
#define DPP_SHR1 0x111
#define DPP_SHL1 0x101
__device__ __forceinline__ float dppf(float old, float src, const int ctrl_sel) {
    int r;
    if (ctrl_sel == 0) r = __builtin_amdgcn_update_dpp(__float_as_int(old), __float_as_int(src), DPP_ROR1, 0xf, 0xf, false);
    else if (ctrl_sel == 1) r = __builtin_amdgcn_update_dpp(__float_as_int(old), __float_as_int(src), DPP_ROR15, 0xf, 0xf, false);
    else if (ctrl_sel == 2) r = __builtin_amdgcn_update_dpp(__float_as_int(old), __float_as_int(src), DPP_SHR1, 0xf, 0xf, false);
    else r = __builtin_amdgcn_update_dpp(__float_as_int(old), __float_as_int(src), DPP_SHL1, 0xf, 0xf, false);
    return __int_as_float(r);
}
struct EpiConv {
    static constexpr bool PERM = true, NEEDS_LDS = true;
    bf16_t* ACTp; float* UH; const float* fw;
    __device__ __forceinline__ void operator()(const f32x4 (&acc)[2][2][4][2], const Unit& u, int wr, int wc, int fr, int fq, LAS unsigned char* lds) const {
        LAS float* XB = (LAS float*)(lds + LDS_XB);
        const int chl = wc * 32 + 8 * fq;
        const int ch = u.pn * 128 + chl;
#pragma unroll
        for (int ai = 0; ai < 2; ++ai) {
            const int blk = 2 * ai + wr;
#pragma unroll
            for (int bj = 0; bj < 2; ++bj)
#pragma unroll
                for (int n = 0; n < 2; ++n) {
                    if (fr == 0) *(LAS f32x4*)(XB + (2 * blk) * 256 + bj * 128 + chl + 4 * n) = acc[ai][bj][0][n];
                    if (fr == 15) *(LAS f32x4*)(XB + (2 * blk + 1) * 256 + bj * 128 + chl + 4 * n) = acc[ai][bj][3][n];
                }
        }
        float wg[3][8], wv[3][8];
#pragma unroll
        for (int t3 = 0; t3 < 3; ++t3) { const f32x4 a0 = *(const f32x4*)(fw + t3 * 5632 + ch), a1 = *(const f32x4*)(fw + t3 * 5632 + ch + 4);
            const f32x4 b0 = *(const f32x4*)(fw + t3 * 5632 + 2816 + ch), b1 = *(const f32x4*)(fw + t3 * 5632 + 2816 + ch + 4);
#pragma unroll
            for (int e = 0; e < 4; ++e) { wg[t3][e] = a0[e]; wg[t3][4 + e] = a1[e]; wv[t3][e] = b0[e]; wv[t3][4 + e] = b1[e]; } }
        asm volatile("s_waitcnt lgkmcnt(0)" ::: "memory"); __builtin_amdgcn_s_barrier(); asm volatile("" ::: "memory");
        {
            float* uh = UH + (size_t)u.pm * 4 * 5632 + u.pn * 256 + chl;
            if (wr == 0 && fr < 2) {
#pragma unroll
                for (int bj = 0; bj < 2; ++bj)
#pragma unroll
                    for (int n = 0; n < 2; ++n) *(f32x4*)(uh + (size_t)fr * 5632 + bj * 128 + 4 * n) = acc[0][bj][0][n];
            }
            if (wr == 1 && fr >= 14) {
#pragma unroll
                for (int bj = 0; bj < 2; ++bj)
#pragma unroll
                    for (int n = 0; n < 2; ++n) *(f32x4*)(uh + (size_t)(fr - 12) * 5632 + bj * 128 + 4 * n) = acc[1][bj][3][n];
            }
        }
#pragma unroll
        for (int ai = 0; ai < 2; ++ai) {
            const int blk = 2 * ai + wr;
#pragma unroll
            for (int m = 0; m < 4; ++m) {
                const int trow = 64 * blk + 16 * m + fr;
                float og[8], ov[8];
#pragma unroll
                for (int bj = 0; bj < 2; ++bj)
#pragma unroll
                    for (int n = 0; n < 2; ++n) {
                        f32x4 pv, nv;
                        if (m == 0) pv = (blk > 0) ? *(const LAS f32x4*)(XB + (2 * blk - 1) * 256 + bj * 128 + chl + 4 * n) : (f32x4){0.f, 0.f, 0.f, 0.f};
                        if (m == 3) nv = (blk < 3) ? *(const LAS f32x4*)(XB + (2 * blk + 2) * 256 + bj * 128 + chl + 4 * n) : (f32x4){0.f, 0.f, 0.f, 0.f};
#pragma unroll
                        for (int e = 0; e < 4; ++e) {
                            const float cur = acc[ai][bj][m][n][e];
                            const float upB = (m == 0) ? pv[e] : dppf(0.f, acc[ai][bj][m == 0 ? 0 : m - 1][n][e], 0);
                            const float dnB = (m == 3) ? nv[e] : dppf(0.f, acc[ai][bj][m == 3 ? 3 : m + 1][n][e], 1);
                            const float up = dppf(upB, cur, 2), dn = dppf(dnB, cur, 3);
                            const int k = 4 * n + e;
                            if (bj == 0) og[k] = wg[0][k] * up + wg[1][k] * cur + wg[2][k] * dn;
                            else         ov[k] = wv[0][k] * up + wv[1][k] * cur + wv[2][k] * dn;
                        }
                    }
                u32x4 ow;
#pragma unroll
                for (int e2 = 0; e2 < 4; ++e2) ow[e2] = pk2(gelu_tanh(og[2 * e2]) * ov[2 * e2], gelu_tanh(og[2 * e2 + 1]) * ov[2 * e2 + 1]);
                if (trow != 0 && trow != 255) *(u32x4*)(ACTp + (size_t)(u.pm * BM + trow) * DFF + ch) = ow;
            }
        }
    }
};

template <class Epi, bool ALIGN_EPI>
__device__ __forceinline__ void gemm_phase(LAS unsigned char* lds, const Gemm g, const StaticOrder& S, const Epi& E) {
    int tid = threadIdx.x; asm volatile("" : "+v"(tid));
    const int wid = __builtin_amdgcn_readfirstlane(tid >> 6), lane = tid & 63, wr = wid >> 2, wc = wid & 3, fr = lane & 15, fq = lane >> 4;
    const int K = g.K, nt = K / BK, lda = g.lda;
    unsigned voffA[2], voffB[2];
#pragma unroll
    for (int i = 0; i < 2; ++i) { int R, C; stage_rc(tid * 16 + i * 8192, R, C); const int Rb = Epi::PERM ? ((R & ~31) + perm32(R & 31)) : R;
        voffA[i] = (unsigned)(R * lda + C) * 2u; voffB[i] = (unsigned)(Rb * K + C) * 2u; }
    const size_t kstep = (size_t)(BK * 2);
    const size_t hstepA = (size_t)HALF * lda * 2, hstepB = (size_t)HALF * K * 2;
    const size_t tstepA = 2 * hstepA, tstepB = 2 * hstepB;
    const unsigned ldsw = (unsigned)wid * 1024u;
    const int aoff = lds_byte(wr * 64 + fr, fq * 8), boff = lds_byte(wc * 32 + fr, fq * 8);
#define PG8_SA(b, h) (((b) * 2 + (h)) * HTB)
#define PG8_SB(b, h) ((4 + (b) * 2 + (h)) * HTB)
#define PG8_STAGE(bufoff, gbase, voff) do { _Pragma("unroll") for (int _i = 0; _i < 2; ++_i) \
        __builtin_amdgcn_global_load_lds((const unsigned*)((const char*)(gbase) + (voff)[_i]), (LAS unsigned*)(lds + (bufoff) + ldsw + _i * 8192), 16, 0, 0); } while (0)
#define PG8_LDA(dst, b, h) do { _Pragma("unroll") for (int m = 0; m < 4; ++m) _Pragma("unroll") for (int k = 0; k < 2; ++k) dst[m][k] = *(const LAS bf16x8*)(lds + PG8_SA(b, h) + aoff + m * 2048 + k * 1024); } while (0)
#define PG8_LDB(dst, b, h) do { _Pragma("unroll") for (int n = 0; n < 2; ++n) _Pragma("unroll") for (int k = 0; k < 2; ++k) dst[n][k] = *(const LAS bf16x8*)(lds + PG8_SB(b, h) + boff + n * 2048 + k * 1024); } while (0)
#define PG8_MMA(ai, bj, At, Bt) do { __builtin_amdgcn_s_setprio(1); _Pragma("unroll") for (int m = 0; m < 4; ++m) _Pragma("unroll") for (int n = 0; n < 2; ++n) _Pragma("unroll") for (int k = 0; k < 2; ++k) \
        acc[ai][bj][m][n] = __builtin_amdgcn_mfma_f32_16x16x32_bf16(Bt[n][k], At[m][k], acc[ai][bj][m][n], 0, 0, 0); __builtin_amdgcn_s_setprio(0); } while (0)
#define PG8_WAIT_V(n) asm volatile("s_waitcnt vmcnt(" #n ")" ::: "memory")
#define PG8_WAIT_L(n) asm volatile("s_waitcnt lgkmcnt(" #n ")" ::: "memory")
#define PG8_BAR __builtin_amdgcn_s_barrier()
#define PG8_SCHED __builtin_amdgcn_sched_barrier(0)
    Unit cur, nxt; int ui = 0;
    if (!S.next(0, cur)) return;
    f32x4 acc[2][2][4][2];
#pragma unroll
    for (int a = 0; a < 2; ++a)
#pragma unroll
        for (int b = 0; b < 2; ++b)
#pragma unroll
            for (int m = 0; m < 4; ++m)
#pragma unroll
                for (int n = 0; n < 2; ++n) acc[a][b][m][n] = (f32x4){0.f, 0.f, 0.f, 0.f};
    bf16x8 At[4][2], B0[2][2], B1[2][2];
    const char* cA = (const char*)g.A + (size_t)cur.pm * tstepA; const char* cB = (const char*)g.Bt + (size_t)cur.pn * tstepB;
    PG8_STAGE(PG8_SB(0, 0), cB, voffB); PG8_STAGE(PG8_SB(0, 1), cB + hstepB, voffB); PG8_STAGE(PG8_SA(0, 0), cA, voffA); PG8_STAGE(PG8_SA(0, 1), cA + hstepA, voffA);
    if (wr == 1) PG8_BAR;
    PG8_WAIT_V(2); PG8_BAR;
    PG8_STAGE(PG8_SB(1, 0), cB + kstep, voffB); PG8_STAGE(PG8_SA(1, 0), cA + kstep, voffA); PG8_STAGE(PG8_SB(1, 1), cB + hstepB + kstep, voffB);
    PG8_WAIT_V(6); PG8_BAR;
    for (;;) {
        const bool has_next = S.next(ui + 1, nxt);
        const char* nA = has_next ? (const char*)g.A + (size_t)nxt.pm * tstepA : cA; const char* nB = has_next ? (const char*)g.Bt + (size_t)nxt.pn * tstepB : cB;
#pragma unroll 1
        for (int t = 0; t < nt; t += 2) {
            const bool last = (t == nt - 2);
            const char* a1 = cA + (size_t)(t + 1) * kstep;
            const char* a2 = last ? nA : cA + (size_t)(t + 2) * kstep; const char* b2 = last ? nB : cB + (size_t)(t + 2) * kstep;
            const char* a3 = a2 + kstep; const char* b3 = b2 + kstep;
            PG8_LDB(B0, 0, 0); PG8_LDB(B1, 0, 1); PG8_SCHED; PG8_LDA(At, 0, 0); PG8_STAGE(PG8_SA(1, 1), a1 + hstepA, voffA);
            PG8_WAIT_V(8); PG8_WAIT_L(0); PG8_BAR; PG8_MMA(0, 0, At, B0); PG8_MMA(0, 1, At, B1); PG8_BAR; PG8_SCHED;
            PG8_LDA(At, 0, 1); PG8_STAGE(PG8_SB(0, 0), b2, voffB); PG8_STAGE(PG8_SB(0, 1), b2 + hstepB, voffB); PG8_STAGE(PG8_SA(0, 0), a2, voffA);
            PG8_WAIT_V(8); PG8_WAIT_L(0); PG8_BAR; PG8_MMA(1, 0, At, B0); PG8_MMA(1, 1, At, B1); PG8_BAR; PG8_SCHED;
            PG8_LDB(B0, 1, 0); PG8_LDB(B1, 1, 1); PG8_SCHED; PG8_LDA(At, 1, 0); PG8_STAGE(PG8_SA(0, 1), a2 + hstepA, voffA);
            PG8_WAIT_V(8); PG8_WAIT_L(0); PG8_BAR; PG8_MMA(0, 0, At, B0); PG8_MMA(0, 1, At, B1); PG8_BAR; PG8_SCHED;
            PG8_LDA(At, 1, 1); PG8_STAGE(PG8_SB(1, 0), b3, voffB); PG8_STAGE(PG8_SB(1, 1), b3 + hstepB, voffB); PG8_STAGE(PG8_SA(1, 0), a3, voffA);
            PG8_WAIT_V(8); PG8_WAIT_L(0); PG8_BAR; PG8_MMA(1, 0, At, B0); PG8_MMA(1, 1, At, B1); PG8_BAR; PG8_SCHED;
        }
        if constexpr (ALIGN_EPI) { if (wr == 0) PG8_BAR; }
        if constexpr (Epi::NEEDS_LDS) E(acc, cur, wr, wc, fr, fq, lds); else E(acc, cur, wr, wc, fr, fq);
        if (!has_next) break;
#pragma unroll
        for (int a = 0; a < 2; ++a)
#pragma unroll
            for (int b = 0; b < 2; ++b)
#pragma unroll
                for (int m = 0; m < 4; ++m)
#pragma unroll
                    for (int n = 0; n < 2; ++n) acc[a][b][m][n] = (f32x4){0.f, 0.f, 0.f, 0.f};
        cur = nxt; cA = nA; cB = nB; ++ui;
        if constexpr (ALIGN_EPI) { if (wr == 1) PG8_BAR; }
    }
    PG8_WAIT_V(0);
    if constexpr (!ALIGN_EPI) { if (wr == 0) PG8_BAR; }
    PG8_BAR;
#undef PG8_SA
#undef PG8_SB
#undef PG8_STAGE
#undef PG8_LDA
#undef PG8_LDB
#undef PG8_MMA
#undef PG8_WAIT_V
#undef PG8_WAIT_L
#undef PG8_BAR
#undef PG8_SCHED
}
}

__device__ __forceinline__ void store_row_t21(bf16_t* ob, const f32x16& o0, const f32x16& o1, float inv, int h) {
#pragma unroll
    for (int db = 0; db < 2; ++db)
#pragma unroll
        for (int gp = 0; gp < 2; ++gp) {
            const int g0 = 2 * gp, g1 = 2 * gp + 1;
            u32x2 a, b;
            if (db == 0) { a.x = pk2(o0[4 * g0] * inv, o0[4 * g0 + 1] * inv); a.y = pk2(o0[4 * g0 + 2] * inv, o0[4 * g0 + 3] * inv);
                           b.x = pk2(o0[4 * g1] * inv, o0[4 * g1 + 1] * inv); b.y = pk2(o0[4 * g1 + 2] * inv, o0[4 * g1 + 3] * inv); }
            else         { a.x = pk2(o1[4 * g0] * inv, o1[4 * g0 + 1] * inv); a.y = pk2(o1[4 * g0 + 2] * inv, o1[4 * g0 + 3] * inv);
                           b.x = pk2(o1[4 * g1] * inv, o1[4 * g1 + 1] * inv); b.y = pk2(o1[4 * g1 + 2] * inv, o1[4 * g1 + 3] * inv); }
            { auto r = __builtin_amdgcn_permlane32_swap(a.x, b.x, false, false); a.x = r[0]; b.x = r[1]; }
            { auto r = __builtin_amdgcn_permlane32_swap(a.y, b.y, false, false); a.y = r[0]; b.y = r[1]; }
            u32x4 w; w.x = a.x; w.y = a.y; w.z = b.x; w.w = b.y;
            *(u32x4*)(ob + 32 * db + 16 * gp + 8 * h) = w;
        }
}
struct AU {
    const bf16_t* Q; const bf16_t* K1; const bf16_t* K2; const bf16_t* V; bf16_t* O; float* LSE; const float* lut;
    int qpitch, k1pitch, k2pitch, vpitch, opitch, lsepitch;
    int R, q0, kt_lo, kt_hi;
    float sc, m0, l0;
};
constexpr int AT_KBUF = 64 * 208, AT_VBUF = 64 * 192, AT_LUT = 2 * AT_KBUF + 2 * AT_VBUF, AT_PAD = 128;

template <int DK, bool BANDED>
__device__ __forceinline__ void attn_unit(LAS unsigned char* lds, const AU& u, int tid, int wid, int lane) {
    constexpr int KP = DK * 2 + 16, VP = 192, NKS = DK / 16;
    const int r = lane & 31, h = lane >> 5;
    const int qidx = u.q0 + 32 * wid + r;
    LAS float* lut = (LAS float*)(lds + AT_LUT);
    if (BANDED) { for (int i = tid; i < 2 * u.R + 1 + 2 * AT_PAD; i += NTHREADS) { const int j = i - AT_PAD; lut[i] = (j >= 0 && j <= 2 * u.R) ? u.lut[j] : -1e30f; } }
    bf16x8 qf[NKS];
    { const bf16_t* qp = u.Q + (size_t)qidx * u.qpitch + 8 * h;
#pragma unroll
      for (int ks = 0; ks < NKS; ++ks) qf[ks] = *(const bf16x8*)(qp + 16 * ks); }
    float m = u.m0, l = u.l0;
    f32x16 o0, o1;
#pragma unroll
    for (int i = 0; i < 16; ++i) { o0[i] = 0.f; o1[i] = 0.f; }
    const int skey = tid >> 3, sch = tid & 7, skey2 = tid >> 2, sch2 = tid & 3;
    u32x4 kreg, vreg, k2reg = {0u, 0u, 0u, 0u};
#define AT_LOAD(kt_) do { const size_t key_ = (size_t)(64 * (kt_) + skey); \
        kreg = *(const u32x4*)(u.K1 + key_ * u.k1pitch + 8 * sch); vreg = *(const u32x4*)(u.V + key_ * u.vpitch + 8 * sch); \
        if (DK == 96 && tid < 256) k2reg = *(const u32x4*)(u.K2 + (size_t)(64 * (kt_) + skey2) * u.k2pitch + 8 * sch2); } while (0)
    const int qlo = u.q0 + 32 * wid, qhi = qlo + 31;
    AT_LOAD(u.kt_lo);
    for (int kt = u.kt_lo; kt < u.kt_hi; ++kt) {
        const int buf = (kt - u.kt_lo) & 1;
        LAS unsigned char* Kb = lds + buf * AT_KBUF; LAS unsigned char* Vb = lds + 2 * AT_KBUF + buf * AT_VBUF;
        *(LAS u32x4*)(Kb + skey * KP + 16 * sch) = kreg;
        *(LAS u32x4*)(Vb + skey * VP + 16 * sch) = vreg;
        if (DK == 96 && tid < 256) *(LAS u32x4*)(Kb + skey2 * KP + 128 + 16 * sch2) = k2reg;
        __syncthreads();
        if (kt + 1 < u.kt_hi) AT_LOAD(kt + 1);
        const bool active = !BANDED || ((64 * kt + 63 >= qlo - u.R) && (64 * kt <= qhi + u.R));
        if (active) {
            f32x16 p0, p1;
#pragma unroll
            for (int i = 0; i < 16; ++i) { p0[i] = 0.f; p1[i] = 0.f; }
#pragma unroll
            for (int ks = 0; ks < NKS; ++ks) {
                const bf16x8 a0 = *(const LAS bf16x8*)(Kb + r * KP + (16 * ks + 8 * h) * 2);
                const bf16x8 a1 = *(const LAS bf16x8*)(Kb + (32 + r) * KP + (16 * ks + 8 * h) * 2);
                p0 = __builtin_amdgcn_mfma_f32_32x32x16_bf16(a0, qf[ks], p0, 0, 0, 0);
                p1 = __builtin_amdgcn_mfma_f32_32x32x16_bf16(a1, qf[ks], p1, 0, 0, 0);
            }
            __builtin_amdgcn_sched_barrier(0);
            float mx = -1e30f;
            const LAS float* lb = lut + (64 * kt + 4 * h - qidx + u.R + AT_PAD);
#pragma unroll
            for (int i = 0; i < 16; ++i) {
                float s0 = p0[i] * u.sc, s1 = p1[i] * u.sc;
                if (BANDED) { s0 += lb[(i & 3) + 8 * (i >> 2)]; s1 += lb[32 + (i & 3) + 8 * (i >> 2)]; }
                p0[i] = s0; p1[i] = s1; mx = fmaxf(mx, fmaxf(s0, s1));
            }
            mx = fmaxf(mx, __shfl_xor(mx, 32));
            const float mn = fmaxf(m, mx), alpha = __builtin_amdgcn_exp2f(m - mn); m = mn;
            float rs = 0.f;
#pragma unroll
            for (int i = 0; i < 16; ++i) { p0[i] = __builtin_amdgcn_exp2f(p0[i] - mn); p1[i] = __builtin_amdgcn_exp2f(p1[i] - mn); rs += p0[i] + p1[i]; }
            rs += __shfl_xor(rs, 32);
            l = l * alpha + rs;
#pragma unroll
            for (int i = 0; i < 16; ++i) { o0[i] *= alpha; o1[i] *= alpha; }
            __builtin_amdgcn_sched_barrier(0);
            const int trow = 4 * h + ((lane & 15) >> 2), tcol = (16 * ((lane >> 4) & 1) + 4 * (lane & 3)) * 2;
#pragma unroll
            for (int hf = 0; hf < 2; ++hf)
#pragma unroll
                for (int s = 0; s < 2; ++s) {
                    u32x4 xw;
                    if (hf == 0) { xw.x = pk2(p0[8 * s], p0[8 * s + 1]); xw.y = pk2(p0[8 * s + 2], p0[8 * s + 3]); xw.z = pk2(p0[8 * s + 4], p0[8 * s + 5]); xw.w = pk2(p0[8 * s + 6], p0[8 * s + 7]); }
                    else         { xw.x = pk2(p1[8 * s], p1[8 * s + 1]); xw.y = pk2(p1[8 * s + 2], p1[8 * s + 3]); xw.z = pk2(p1[8 * s + 4], p1[8 * s + 5]); xw.w = pk2(p1[8 * s + 6], p1[8 * s + 7]); }
                    const bf16x8 xs = __builtin_bit_cast(bf16x8, xw);
                    const LAS unsigned char* vp = Vb + (32 * hf + 16 * s + trow) * VP + tcol;
                    const s16x4 lo0 = __builtin_bit_cast(s16x4, __builtin_amdgcn_ds_read_tr16_b64_v4i16((LAS s16x4*)(vp)));
                    const s16x4 hi0 = __builtin_bit_cast(s16x4, __builtin_amdgcn_ds_read_tr16_b64_v4i16((LAS s16x4*)(vp + 8 * VP)));
                    const s16x4 lo1 = __builtin_bit_cast(s16x4, __builtin_amdgcn_ds_read_tr16_b64_v4i16((LAS s16x4*)(vp + 64)));
                    const s16x4 hi1 = __builtin_bit_cast(s16x4, __builtin_amdgcn_ds_read_tr16_b64_v4i16((LAS s16x4*)(vp + 8 * VP + 64)));
                    const bf16x8 pa0 = __builtin_shufflevector(lo0, hi0, 0, 1, 2, 3, 4, 5, 6, 7);
                    const bf16x8 pa1 = __builtin_shufflevector(lo1, hi1, 0, 1, 2, 3, 4, 5, 6, 7);
                    o0 = __builtin_amdgcn_mfma_f32_32x32x16_bf16(pa0, xs, o0, 0, 0, 0);
                    o1 = __builtin_amdgcn_mfma_f32_32x32x16_bf16(pa1, xs, o1, 0, 0, 0);
                }
        }
    }
#undef AT_LOAD
    {
        const float inv = 1.f / l;
        bf16_t* op = u.O + (size_t)qidx * u.opitch + 4 * h;
#pragma unroll
        for (int g = 0; g < 4; ++g) {
            u32x2 w0, w1;
            w0.x = pk2(o0[4 * g] * inv, o0[4 * g + 1] * inv); w0.y = pk2(o0[4 * g + 2] * inv, o0[4 * g + 3] * inv);
            w1.x = pk2(o1[4 * g] * inv, o1[4 * g + 1] * inv); w1.y = pk2(o1[4 * g + 2] * inv, o1[4 * g + 3] * inv);
            *(u32x2*)(op + 8 * g) = w0; *(u32x2*)(op + 32 + 8 * g) = w1;
        }
        if (u.LSE && h == 0) u.LSE[(size_t)qidx * u.lsepitch] = m + __builtin_amdgcn_logf(l);
    }
    __syncthreads();
}


constexpr int AC_KP = 208, AC_VP = 192, AC_KBUF = 64 * AC_KP, AC_VBUF = 64 * AC_VP, AC_VOFF = 2 * AC_KBUF;
__device__ __forceinline__ void attn_unit_c(LAS unsigned char* lds, const AU& u, int tid, int wid, int lane) {
    constexpr int NT = SEQ / 64;
    const int r = lane & 31, h = lane >> 5;
    const int qidx = u.q0 + 32 * wid + r;
    bf16x8 qf[6];
    { const bf16_t* qp = u.Q + (size_t)qidx * u.qpitch + 8 * h;
#pragma unroll
      for (int ks = 0; ks < 6; ++ks) qf[ks] = *(const bf16x8*)(qp + 16 * ks); }
    float m = -1e30f, l = 0.f;
    f32x16 o0, o1;
#pragma unroll
    for (int i = 0; i < 16; ++i) { o0[i] = 0.f; o1[i] = 0.f; }
    const int skey = tid >> 3, sch = tid & 7, skey2 = tid >> 2, sch2 = tid & 3;
    u32x4 kreg, vreg, k2reg = {0u, 0u, 0u, 0u};
    const bf16_t* kp1 = u.K1 + (size_t)skey * u.k1pitch + 8 * sch;
    const bf16_t* vp1 = u.V + (size_t)skey * u.vpitch + 8 * sch;
    const bf16_t* kp2 = u.K2 + (size_t)skey2 * u.k2pitch + 8 * sch2;
#define AC_LOAD(kt_) do { kreg = *(const u32x4*)(kp1 + (size_t)(64 * (kt_)) * u.k1pitch); vreg = *(const u32x4*)(vp1 + (size_t)(64 * (kt_)) * u.vpitch); \
        if (tid < 256) k2reg = *(const u32x4*)(kp2 + (size_t)(64 * (kt_)) * u.k2pitch); } while (0)
#define AC_STORE(kt_) do { LAS unsigned char* Kb_ = lds + ((kt_) & 1) * AC_KBUF; LAS unsigned char* Vb_ = lds + AC_VOFF + ((kt_) % 3) * AC_VBUF; \
        *(LAS u32x4*)(Kb_ + skey * AC_KP + 16 * sch) = kreg; *(LAS u32x4*)(Vb_ + skey * AC_VP + 16 * sch) = vreg; \
        if (tid < 256) *(LAS u32x4*)(Kb_ + skey2 * AC_KP + 128 + 16 * sch2) = k2reg; } while (0)
#define AC_QK(P0, P1, kt_) do { const LAS unsigned char* Kb_ = lds + ((kt_) & 1) * AC_KBUF + r * AC_KP + 16 * h; \
        bf16x8 ka_[6], kb_[6]; \
        _Pragma("unroll") for (int ks = 0; ks < 6; ++ks) { ka_[ks] = *(const LAS bf16x8*)(Kb_ + 32 * ks); kb_[ks] = *(const LAS bf16x8*)(Kb_ + 32 * AC_KP + 32 * ks); } \
        _Pragma("unroll") for (int i_ = 0; i_ < 16; ++i_) { P0[i_] = negm; P1[i_] = negm; } \
        _Pragma("unroll") for (int ks = 0; ks < 6; ++ks) { \
            P0 = __builtin_amdgcn_mfma_f32_32x32x16_bf16(ka_[ks], qf[ks], P0, 0, 0, 0); P1 = __builtin_amdgcn_mfma_f32_32x32x16_bf16(kb_[ks], qf[ks], P1, 0, 0, 0); } } while (0)
    const int trow = 4 * h + ((lane & 15) >> 2), tcol = (16 * ((lane >> 4) & 1) + 4 * (lane & 3)) * 2;
#define AC_SOFTMAX_PV(P0, P1, N0, N1, kt_) do { \
          \
        float rq_[4] = {0.f, 0.f, 0.f, 0.f}; int mq_[4];     \
        _Pragma("unroll") for (int i_ = 0; i_ < 16; ++i_) { P0[i_] = __builtin_amdgcn_exp2f(P0[i_]); P1[i_] = __builtin_amdgcn_exp2f(P1[i_]); rq_[i_ & 3] += P0[i_] + P1[i_]; \
            if (i_ < 4) mq_[i_] = max(__float_as_int(P0[i_]), __float_as_int(P1[i_])); else mq_[i_ & 3] = max(max(mq_[i_ & 3], __float_as_int(P0[i_])), __float_as_int(P1[i_])); } \
        const LAS unsigned char* Vb_ = lds + AC_VOFF + ((kt_) % 3) * AC_VBUF + trow * AC_VP + tcol; \
        s16x4 vl0_[4], vh0_[4], vl1_[4], vh1_[4]; \
        _Pragma("unroll") for (int q_ = 0; q_ < 4; ++q_) { const LAS unsigned char* vp_ = Vb_ + (16 * q_) * AC_VP; \
            vl0_[q_] = __builtin_bit_cast(s16x4, __builtin_amdgcn_ds_read_tr16_b64_v4i16((LAS s16x4*)(vp_))); \
            vh0_[q_] = __builtin_bit_cast(s16x4, __builtin_amdgcn_ds_read_tr16_b64_v4i16((LAS s16x4*)(vp_ + 8 * AC_VP))); \
            vl1_[q_] = __builtin_bit_cast(s16x4, __builtin_amdgcn_ds_read_tr16_b64_v4i16((LAS s16x4*)(vp_ + 64))); \
            vh1_[q_] = __builtin_bit_cast(s16x4, __builtin_amdgcn_ds_read_tr16_b64_v4i16((LAS s16x4*)(vp_ + 8 * AC_VP + 64))); } \
        _Pragma("unroll") for (int hf = 0; hf < 2; ++hf) _Pragma("unroll") for (int s = 0; s < 2; ++s) { \
            u32x4 xw_; \
            if (hf == 0) { xw_.x = pk2(P0[8 * s], P0[8 * s + 1]); xw_.y = pk2(P0[8 * s + 2], P0[8 * s + 3]); xw_.z = pk2(P0[8 * s + 4], P0[8 * s + 5]); xw_.w = pk2(P0[8 * s + 6], P0[8 * s + 7]); } \
            else         { xw_.x = pk2(P1[8 * s], P1[8 * s + 1]); xw_.y = pk2(P1[8 * s + 2], P1[8 * s + 3]); xw_.z = pk2(P1[8 * s + 4], P1[8 * s + 5]); xw_.w = pk2(P1[8 * s + 6], P1[8 * s + 7]); } \
            const bf16x8 xs_ = __builtin_bit_cast(bf16x8, xw_); \
            o0 = __builtin_amdgcn_mfma_f32_32x32x16_bf16(__builtin_shufflevector(vl0_[2 * hf + s], vh0_[2 * hf + s], 0, 1, 2, 3, 4, 5, 6, 7), xs_, o0, 0, 0, 0); \
            o1 = __builtin_amdgcn_mfma_f32_32x32x16_bf16(__builtin_shufflevector(vl1_[2 * hf + s], vh1_[2 * hf + s], 0, 1, 2, 3, 4, 5, 6, 7), xs_, o1, 0, 0, 0); } \
        float rs_ = (rq_[0] + rq_[1]) + (rq_[2] + rq_[3]); \
        rs_ += __shfl_xor(rs_, 32); l += rs_; \
        int emi_ = max(max(max(mq_[0], mq_[1]), mq_[2]), mq_[3]); \
        emi_ = max(emi_, __shfl_xor(emi_, 32)); \
        const float em_ = __int_as_float(emi_); \
        if ((kt_) == 0 || __builtin_amdgcn_ballot_w64(em_ > 256.0f) != 0ull) { \
            const float ec_ = (kt_) == 0 ? fmaxf(em_, 1e-30f) : fmaxf(em_, 1.f); \
            const float dl_ = __builtin_amdgcn_logf(ec_), al_ = __builtin_amdgcn_exp2f(-dl_); l *= al_; \
            _Pragma("unroll") for (int i_ = 0; i_ < 16; ++i_) { o0[i_] *= al_; o1[i_] *= al_; N0[i_] -= dl_; N1[i_] -= dl_; } negm -= dl_; } } while (0)
    f32x16 pA0, pA1, pB0, pB1; float negm = 0.f;
#pragma unroll
    for (int i = 0; i < 16; ++i) { pB0[i] = 0.f; pB1[i] = 0.f; }
    AC_LOAD(0); AC_STORE(0);
    __syncthreads();
    AC_LOAD(1);
    AC_QK(pA0, pA1, 0);
    for (int t = 0; t < NT; t += 2) {
        AC_STORE(t + 1);
        __syncthreads();
        if (t + 2 < NT) AC_LOAD(t + 2);
        AC_QK(pB0, pB1, t + 1);
        AC_SOFTMAX_PV(pA0, pA1, pB0, pB1, t);
        if (t + 2 < NT) AC_STORE(t + 2);
        __syncthreads();
        if (t + 3 < NT) AC_LOAD(t + 3);
        if (t + 2 < NT) AC_QK(pA0, pA1, t + 2);
        AC_SOFTMAX_PV(pB0, pB1, pA0, pA1, t + 1);
    }
#undef AC_LOAD
#undef AC_STORE
#undef AC_QK
#undef AC_SOFTMAX_PV
    {
        const float inv = 1.f / l;
        store_row_t21(u.O + (size_t)qidx * u.opitch, o0, o1, inv, h);
    }
    __syncthreads();
}

constexpr int BW_VP = 192, BW_VBYTES = 64 * BW_VP, BW_LUT = 8 * BW_VBYTES;
__device__ __forceinline__ void attn_unit_w(LAS unsigned char* lds, const AU& u, int tid, int wid, int lane) {
    const int r = lane & 31, h = lane >> 5;
    const int qidx = u.q0 + 32 * wid + r;
    LAS float* lut = (LAS float*)(lds + BW_LUT);
    for (int i = tid; i < 2 * u.R + 1 + 2 * AT_PAD; i += NTHREADS) { const int j = i - AT_PAD; lut[i] = (j >= 0 && j <= 2 * u.R) ? u.lut[j] : -1e30f; }
    bf16x8 qf[4];
    { const bf16_t* qp = u.Q + (size_t)qidx * u.qpitch + 8 * h;
#pragma unroll
      for (int ks = 0; ks < 4; ++ks) qf[ks] = *(const bf16x8*)(qp + 16 * ks); }
    float m = u.m0, l = u.l0;
    f32x16 o0, o1;
#pragma unroll
    for (int i = 0; i < 16; ++i) { o0[i] = 0.f; o1[i] = 0.f; }
    const int qlo = u.q0 + 32 * wid;
    int t_lo = (qlo - u.R) >> 6, t_hi = ((qlo + 31 + u.R) >> 6) + 1;
    t_lo = t_lo < u.kt_lo ? u.kt_lo : t_lo; t_hi = t_hi > u.kt_hi ? u.kt_hi : t_hi;
    LAS unsigned char* Vw = lds + wid * BW_VBYTES;
    const int vkey = lane >> 3, vch = lane & 7;
    bf16x8 kf[8]; u32x4 vr[8];
    const bf16_t* kbase = u.K1 + (size_t)r * u.k1pitch + 8 * h;
    const bf16_t* vbase = u.V + (size_t)vkey * u.vpitch + 8 * vch;
#define BW_LOAD(t_) do { const bf16_t* kp_ = kbase + (size_t)(64 * (t_)) * u.k1pitch; const bf16_t* vp_ = vbase + (size_t)(64 * (t_)) * u.vpitch; \
        _Pragma("unroll") for (int ks = 0; ks < 4; ++ks) { kf[ks] = *(const bf16x8*)(kp_ + 16 * ks); kf[4 + ks] = *(const bf16x8*)(kp_ + (size_t)32 * u.k1pitch + 16 * ks); } \
        _Pragma("unroll") for (int j = 0; j < 8; ++j) vr[j] = *(const u32x4*)(vp_ + (size_t)(8 * j) * u.vpitch); } while (0)
    __syncthreads();
    if (t_lo < t_hi) BW_LOAD(t_lo);
    const int trow = 4 * h + ((lane & 15) >> 2), tcol = (16 * ((lane >> 4) & 1) + 4 * (lane & 3)) * 2;
    for (int kt = t_lo; kt < t_hi; ++kt) {
#pragma unroll
        for (int j = 0; j < 8; ++j) *(LAS u32x4*)(Vw + (vkey + 8 * j) * BW_VP + 16 * vch) = vr[j];
        bf16x8 kc[8];
#pragma unroll
        for (int i = 0; i < 8; ++i) kc[i] = kf[i];
        if (kt + 1 < t_hi) BW_LOAD(kt + 1);
        f32x16 p0, p1;
#pragma unroll
        for (int i = 0; i < 16; ++i) { p0[i] = 0.f; p1[i] = 0.f; }
#pragma unroll
        for (int ks = 0; ks < 4; ++ks) {
            p0 = __builtin_amdgcn_mfma_f32_32x32x16_bf16(kc[ks], qf[ks], p0, 0, 0, 0);
            p1 = __builtin_amdgcn_mfma_f32_32x32x16_bf16(kc[4 + ks], qf[ks], p1, 0, 0, 0);
        }
        const LAS float* lb = lut + (64 * kt + 4 * h - qidx + u.R + AT_PAD);
        float mq[4] = {-1e30f, -1e30f, -1e30f, -1e30f};
#pragma unroll
        for (int i = 0; i < 16; ++i) {
            const float s0 = p0[i] * u.sc + lb[(i & 3) + 8 * (i >> 2)], s1 = p1[i] * u.sc + lb[32 + (i & 3) + 8 * (i >> 2)];
            p0[i] = s0; p1[i] = s1; mq[i & 3] = max3f(mq[i & 3], s0, s1);
        }
        float mx = max2f(max3f(mq[0], mq[1], mq[2]), mq[3]);
        mx = max2f(mx, __shfl_xor(mx, 32));
        if (__builtin_amdgcn_ballot_w64(mx > m + 8.0f) != 0ull) {
            const float mn = fmaxf(m, mx), alpha = __builtin_amdgcn_exp2f(m - mn); m = mn; l *= alpha;
#pragma unroll
            for (int i = 0; i < 16; ++i) { o0[i] *= alpha; o1[i] *= alpha; }
        }
        float rq[4] = {0.f, 0.f, 0.f, 0.f};
#pragma unroll
        for (int i = 0; i < 16; ++i) { p0[i] = __builtin_amdgcn_exp2f(p0[i] - m); p1[i] = __builtin_amdgcn_exp2f(p1[i] - m); rq[i & 3] += p0[i] + p1[i]; }
        float rs = (rq[0] + rq[1]) + (rq[2] + rq[3]);
        rs += __shfl_xor(rs, 32);
        l += rs;
#pragma unroll
        for (int hf = 0; hf < 2; ++hf)
#pragma unroll
            for (int s = 0; s < 2; ++s) {
                u32x4 xw;
                if (hf == 0) { xw.x = pk2(p0[8 * s], p0[8 * s + 1]); xw.y = pk2(p0[8 * s + 2], p0[8 * s + 3]); xw.z = pk2(p0[8 * s + 4], p0[8 * s + 5]); xw.w = pk2(p0[8 * s + 6], p0[8 * s + 7]); }
                else         { xw.x = pk2(p1[8 * s], p1[8 * s + 1]); xw.y = pk2(p1[8 * s + 2], p1[8 * s + 3]); xw.z = pk2(p1[8 * s + 4], p1[8 * s + 5]); xw.w = pk2(p1[8 * s + 6], p1[8 * s + 7]); }
                const bf16x8 xs = __builtin_bit_cast(bf16x8, xw);
                const LAS unsigned char* vp = Vw + (32 * hf + 16 * s + trow) * BW_VP + tcol;
                const s16x4 lo0 = __builtin_bit_cast(s16x4, __builtin_amdgcn_ds_read_tr16_b64_v4i16((LAS s16x4*)(vp)));
                const s16x4 hi0 = __builtin_bit_cast(s16x4, __builtin_amdgcn_ds_read_tr16_b64_v4i16((LAS s16x4*)(vp + 8 * BW_VP)));
                const s16x4 lo1 = __builtin_bit_cast(s16x4, __builtin_amdgcn_ds_read_tr16_b64_v4i16((LAS s16x4*)(vp + 64)));
                const s16x4 hi1 = __builtin_bit_cast(s16x4, __builtin_amdgcn_ds_read_tr16_b64_v4i16((LAS s16x4*)(vp + 8 * BW_VP + 64)));
                o0 = __builtin_amdgcn_mfma_f32_32x32x16_bf16(__builtin_shufflevector(lo0, hi0, 0, 1, 2, 3, 4, 5, 6, 7), xs, o0, 0, 0, 0);
                o1 = __builtin_amdgcn_mfma_f32_32x32x16_bf16(__builtin_shufflevector(lo1, hi1, 0, 1, 2, 3, 4, 5, 6, 7), xs, o1, 0, 0, 0);
            }
    }
#undef BW_LOAD
    {
        int qidx2 = u.q0 + 32 * wid + r; asm volatile("" : "+v"(qidx2));
        const float inv = 1.f / l;
        store_row_t21(u.O + (size_t)qidx2 * u.opitch, o0, o1, inv, h);
        if (u.LSE && h == 0) u.LSE[(size_t)qidx2 * u.lsepitch] = m + __builtin_amdgcn_logf(l);
    }
    __syncthreads();
}

struct Args { const void* in[18]; float* out; unsigned char* ws; };

__device__ __forceinline__ void tr_item(const float* W, int ldw, int k0, int n0, bf16_t* D, int ldd, int drow0, int dk0, LAS float* scr, int lane) {
    if (W) {
        float tv_[32];
#pragma unroll
        for (int i = 0; i < 32; ++i) { const int kk = 2 * i + (lane >> 5); tv_[i] = W[(size_t)(k0 + kk) * ldw + n0 + (lane & 31)]; }
#pragma unroll
        for (int i = 0; i < 32; ++i) { const int kk = 2 * i + (lane >> 5); scr[kk * 33 + (lane & 31)] = tv_[i]; }
    }
    asm volatile("s_waitcnt lgkmcnt(0)" ::: "memory");
    const int c = lane & 7;
#pragma unroll
    for (int j = 0; j < 4; ++j) { const int n = (lane >> 3) + 8 * j; const LAS float* s = scr + (8 * c) * 33 + n;
        unsigned z_ = 0u; asm volatile("" : "+v"(z_)); u32x4 o = {z_, z_, z_, z_};
        if (W) { o.x = pk2(s[0 * 33], s[1 * 33]); o.y = pk2(s[2 * 33], s[3 * 33]); o.z = pk2(s[4 * 33], s[5 * 33]); o.w = pk2(s[6 * 33], s[7 * 33]); }
        *(u32x4*)(D + (size_t)(drow0 + n) * ldd + dk0 + 8 * c) = o; }
    asm volatile("s_waitcnt lgkmcnt(0)" ::: "memory");
}

__device__ __forceinline__ void convert_weights(const float* w_in_, const float* w_uq_, const float* w_ukv_, const float* w_out_, const float* w_up_, const float* w_down_, unsigned char* ws_, int l, LAS unsigned char* lds, int gw, int NGW, int wave, int lane) {
    LAS float* scr = (LAS float*)(lds + wave * 16384);
    unsigned char* ws = ws_;
    const float* w_in = w_in_ + (size_t)l * 1024 * 4000;
    const float* w_uq = w_uq_ + (size_t)l * 256 * 384;
    const float* w_ukv = w_ukv_ + (size_t)l * 128 * 512;
    const float* w_out = w_out_ + (size_t)l * 1024 * 1024;
    const float* w_up = w_up_ + (size_t)l * 1024 * 5632;
    const float* w_down = w_down_ + (size_t)l * 2816 * 1024;
    constexpr int I_IN = 16 * 125, I_OUT = 16 * 32, I_UP = 16 * 176, I_DOWN = 44 * 32, I_MLA = 6 * 32;
    constexpr int NIT = I_IN + I_OUT + I_UP + I_DOWN + I_MLA;
    for (int it = gw; it < NIT; it += NGW) {
        int r = it;
        if (r < I_UP) { const int kb = r / 176, nb = r % 176; const int n0 = 32 * nb;
            int drow; { const int c = n0 < 2816 ? n0 : n0 - 2816; drow = 256 * (c >> 7) + (c & 127) + (n0 < 2816 ? 0 : 128); }
            tr_item(w_up, 5632, 64 * kb, n0, (bf16_t*)(ws + W_UP), 1024, drow, 64 * kb, scr, lane); continue; } r -= I_UP;
        if (r < I_IN) { const int kb = r / 125, nb = r % 125; tr_item(w_in, 4000, 64 * kb, 32 * nb, (bf16_t*)(ws + W_IN), 1024, 32 * nb + (32 * nb >= 1696 ? 96 : 0), 64 * kb, scr, lane); continue; } r -= I_IN;
        if (r < I_DOWN) { const int kb = r / 32, nb = r % 32; tr_item(w_down, 1024, 64 * kb, 32 * nb, (bf16_t*)(ws + W_DOWN), 2816, 32 * nb, 64 * kb, scr, lane); continue; } r -= I_DOWN;
        if (r < I_OUT) { const int kb = r / 32, nb = r % 32; tr_item(w_out, 1024, 64 * kb, 32 * nb, (bf16_t*)(ws + W_OUT), 1024, 32 * nb, 64 * kb, scr, lane); continue; } r -= I_OUT;
        { const int kb = r / 32, nb = r % 32, n0 = 32 * nb; const float* W = nullptr; int ldw = 0, k0 = 0, sn0 = 0;
          if (n0 < 384) { if (kb < 4) { W = w_uq; ldw = 384; k0 = 64 * kb; sn0 = n0; } }
          else if (n0 < 896) { if (kb >= 4) { W = w_ukv; ldw = 512; k0 = 64 * (kb - 4);
                  if (n0 < 640) { const int hk = (n0 - 384) / 64, e0 = (n0 - 384) % 64; sn0 = hk * 128 + e0; } else { const int hv = (n0 - 640) / 64, e0 = (n0 - 640) % 64; sn0 = hv * 128 + 64 + e0; } } }
          tr_item(W, ldw, k0, sn0, (bf16_t*)(ws + W_MLA), 384, n0, 64 * kb, scr, lane); }
    }
}

template <int NR, bool XIN16 = false, bool XOUT16 = false>
__device__ __forceinline__ void row_pass(int row, int rstride, const float* xin, const bf16_t* y, const float* gate, const float* gainY, float* xout,
                                         const float* gainH, const float* sc, const float* sh, bf16_t* hout, int lane) {
    f32x4 xv[NR][4]; f32x4 yv[NR][4];
#pragma unroll
    for (int q = 0; q < NR; ++q) {
        if (XIN16) { const u32x2* xr = (const u32x2*)((const bf16_t*)xin + (size_t)(row + q * rstride) * DM) + lane;
#pragma unroll
            for (int j = 0; j < 4; ++j) xv[q][j] = unpack4(xr[64 * j]); }
        else { const f32x4* xr = (const f32x4*)(xin + (size_t)(row + q * rstride) * DM) + lane;
#pragma unroll
            for (int j = 0; j < 4; ++j) xv[q][j] = xr[64 * j]; } }
    if (y) {
#pragma unroll
        for (int q = 0; q < NR; ++q) { const u32x2* yr = (const u32x2*)(y + (size_t)(row + q * rstride) * DM) + lane;
#pragma unroll
            for (int j = 0; j < 4; ++j) yv[q][j] = unpack4(yr[64 * j]); }
        f32x4 g[4], gy[4];
#pragma unroll
        for (int j = 0; j < 4; ++j) { g[j] = ((const f32x4*)gate)[lane + 64 * j]; gy[j] = ((const f32x4*)gainY)[lane + 64 * j]; }
        float ss[NR];
#pragma unroll
        for (int q = 0; q < NR; ++q) { ss[q] = 0.f;
#pragma unroll
            for (int j = 0; j < 4; ++j) ss[q] += (yv[q][j][0] * yv[q][j][0] + yv[q][j][1] * yv[q][j][1]) + (yv[q][j][2] * yv[q][j][2] + yv[q][j][3] * yv[q][j][3]); }
#pragma unroll
        for (int o = 1; o < 64; o <<= 1) {
#pragma unroll
            for (int q = 0; q < NR; ++q) ss[q] += __shfl_xor(ss[q], o); }
#pragma unroll
        for (int q = 0; q < NR; ++q) { const float rstd = rsqrtf(ss[q] * (1.f / DM) + EPS);
            if (XOUT16) { u32x2* xo = (u32x2*)((bf16_t*)xout + (size_t)(row + q * rstride) * DM) + lane;
#pragma unroll
                for (int j = 0; j < 4; ++j) { xv[q][j] = xv[q][j] + g[j] * (yv[q][j] * rstd * gy[j]); xo[64 * j] = pack4(xv[q][j]); xv[q][j] = unpack4(pack4(xv[q][j])); } }
            else { f32x4* xo = (f32x4*)(xout + (size_t)(row + q * rstride) * DM) + lane;
#pragma unroll
                for (int j = 0; j < 4; ++j) { xv[q][j] = xv[q][j] + g[j] * (yv[q][j] * rstd * gy[j]); xo[64 * j] = xv[q][j]; } } }
    }
    if (hout) {
        f32x4 gh[4], s1[4], s0[4];
#pragma unroll
        for (int j = 0; j < 4; ++j) { gh[j] = ((const f32x4*)gainH)[lane + 64 * j]; s1[j] = ((const f32x4*)sc)[lane + 64 * j]; s0[j] = ((const f32x4*)sh)[lane + 64 * j]; }
        float ss[NR];
#pragma unroll
        for (int q = 0; q < NR; ++q) { ss[q] = 0.f;
#pragma unroll
            for (int j = 0; j < 4; ++j) ss[q] += (xv[q][j][0] * xv[q][j][0] + xv[q][j][1] * xv[q][j][1]) + (xv[q][j][2] * xv[q][j][2] + xv[q][j][3] * xv[q][j][3]); }
#pragma unroll
        for (int o = 1; o < 64; o <<= 1) {
#pragma unroll
            for (int q = 0; q < NR; ++q) ss[q] += __shfl_xor(ss[q], o); }
#pragma unroll
        for (int q = 0; q < NR; ++q) { const float rstd = rsqrtf(ss[q] * (1.f / DM) + EPS);
            u32x2* ho = (u32x2*)(hout + (size_t)(row + q * rstride) * DM) + lane;
#pragma unroll
            for (int j = 0; j < 4; ++j) { const f32x4 hv = (xv[q][j] * rstd * gh[j]) * (1.f + s1[j]) + s0[j]; ho[64 * j] = pack4(hv); } }
    }
}

__device__ __forceinline__ int t5_bucket(int rel) {
    const int n = rel < 0 ? -rel : rel;
    int v;
    if (n < 8) v = n; else { int lg = 8 + (int)(__builtin_amdgcn_logf((float)n * 0.125f) * (8.f / 7.f)); v = lg < 15 ? lg : 15; }
    return (rel > 0 ? 16 : 0) + v;
}


#define XB_TMO      128
#define XB_XCNT(j)  (256  + 64 * (j))
#define XB_XSUB(j)  (1280 + 64 * (j))
#define XB_XGEN(j)  (2304 + 64 * (j))
#define XB_TOP      3328
#define XB_TOPGEN   3392
#define XCD_BAR_WORDS 3456
#define XB_SPIN_CAP (1u << 22)
__device__ __forceinline__ unsigned xb_ld(unsigned* p)              { return __hip_atomic_load(p, __ATOMIC_RELAXED, __HIP_MEMORY_SCOPE_AGENT); }
__device__ __forceinline__ unsigned xb_add(unsigned* p, unsigned v) { return __hip_atomic_fetch_add(p, v, __ATOMIC_RELAXED, __HIP_MEMORY_SCOPE_AGENT); }
__device__ __forceinline__ unsigned xb_xcc_id() { return (unsigned)__builtin_amdgcn_s_getreg((3 << 11) | 20) & 0xFu; }
#define XB_SPIN(cond, bar) do { unsigned _sp = 0; while (cond) { __builtin_amdgcn_s_sleep(1); \
    if ((++_sp & 255u) == 0u) { if (xb_ld(&(bar)[XB_TMO])) break; if (_sp > XB_SPIN_CAP) { atomicAdd(&(bar)[XB_TMO], 1u); break; } } } } while (0)
__device__ __forceinline__ void xcd_barrier_complete(unsigned* bar, unsigned x, unsigned& nloc, unsigned& nx) {
    const unsigned G = gridDim.x;
    unsigned sum, cnt, mine, sp = 0u;
    for (;;) {
        sum = 0u; cnt = 0u; mine = 0u;
#pragma unroll
        for (unsigned j = 0; j < 16; ++j) { const unsigned c = xb_ld(&bar[XB_XCNT(j)]); sum += c; cnt += (c > 0u) ? 1u : 0u; mine = (j == x) ? c : mine; }
        if (sum == G) break;
        __builtin_amdgcn_s_sleep(1);
        if ((++sp & 255u) == 0u) { if (xb_ld(&bar[XB_TMO])) break; if (sp > XB_SPIN_CAP) { atomicAdd(&bar[XB_TMO], 1u); break; } }
    }
    nloc = mine > 0u ? mine : 1u; nx = cnt > 0u ? cnt : 1u;
}
__device__ __forceinline__ void xcd_barrier(unsigned* bar, volatile LAS unsigned* st) {
    asm volatile("s_waitcnt vmcnt(0)" ::: "memory");
    __syncthreads();
    if (threadIdx.x == 0) {
        __builtin_amdgcn_s_waitcnt(0);
        const unsigned x = xb_xcc_id();
        unsigned nloc = st[0], nx = st[1];
        if (nloc == 0u) { xcd_barrier_complete(bar, x, nloc, nx); st[0] = nloc; st[1] = nx; }
        const unsigned old = xb_add(&bar[XB_XSUB(x)], 1u);
        const unsigned gen = old / nloc;
        if (old + 1u == (gen + 1u) * nloc) {
            __builtin_amdgcn_fence(__ATOMIC_RELEASE, "agent");
            asm volatile("s_waitcnt vmcnt(0)" ::: "memory");
            const unsigned og = xb_add(&bar[XB_TOP], 1u);
            const unsigned tg = og / nx;
            if (og + 1u == (tg + 1u) * nx) xb_add(&bar[XB_TOPGEN], 1u);
            else XB_SPIN(xb_ld(&bar[XB_TOPGEN]) == tg, bar);
            __builtin_amdgcn_fence(__ATOMIC_ACQUIRE, "agent");
            xb_add(&bar[XB_XGEN(x)], 1u);
            asm volatile("s_waitcnt vmcnt(0)" ::: "memory");
        } else {
            XB_SPIN(xb_ld(&bar[XB_XGEN(x)]) == gen, bar);
            __builtin_amdgcn_fence(__ATOMIC_ACQUIRE, "agent");
            asm volatile("s_waitcnt vmcnt(0)" ::: "memory");
        }
    }
    __syncthreads();
}
typedef const __attribute__((address_space(4))) Args* CArgsP;
__device__ __forceinline__ CArgsP largs() { CArgsP p = (CArgsP)__builtin_amdgcn_kernarg_segment_ptr(); asm volatile("" : "+s"(p)); return p; }
__device__ __forceinline__ int otid() { int t = threadIdx.x; asm volatile("" : "+v"(t)); return t; }
__global__ void __launch_bounds__(NTHREADS) mega(Args a) {
    extern __shared__ __attribute__((aligned(16))) unsigned char lds_raw[];
    LAS unsigned char* lds = (LAS unsigned char*)lds_raw;
    cg::grid_group grid = cg::this_grid();
    volatile LAS unsigned* bst = (volatile LAS unsigned*)(lds + 131072);
    if (threadIdx.x < 2) bst[threadIdx.x] = 0u;
    __syncthreads();
    if (gridDim.x == 0x7fffffffu) grid.sync();
    { CArgsP ap0 = largs(); unsigned* bar0 = (unsigned*)ap0->ws; if (threadIdx.x == 0) (void)xb_add(&bar0[XB_XCNT(xb_xcc_id())], 1u); }
#define GSYNC() do { CArgsP apb_ = largs(); xcd_barrier((unsigned*)apb_->ws, bst); } while (0)
    const int G = gridDim.x, bid = blockIdx.x;
    const int NGW = G * NWAVES, NGT = G * NTHREADS;
#define PHASE_IDS() const int tid = otid(), lane = tid & 63, wave = __builtin_amdgcn_readfirstlane(tid >> 6); const int gw = bid * NWAVES + wave; const int gt = bid * NTHREADS + tid; (void)gw; (void)gt; (void)lane; PTRS()
#define PTRS() CArgsP ap_ = largs(); unsigned char* ws = ap_->ws; const float* x_in = (const float*)ap_->in[0]; const float* c_in = (const float*)ap_->in[1]; const int* positions = (const int*)ap_->in[2]; const float* rel_bias = (const float*)ap_->in[3]; const float* w_mod = (const float*)ap_->in[4]; const float* b_mod = (const float*)ap_->in[5]; const float* norm_g = (const float*)ap_->in[6]; const float* a_sink = (const float*)ap_->in[8]; const float* b_conv = (const float*)ap_->in[9]; const float* c_norm_q = (const float*)ap_->in[10]; const float* c_norm_kv = (const float*)ap_->in[11]; const float* ffn_conv = (const float*)ap_->in[16]; float* MOD = (float*)(ws + WS_MOD); float* CS = (float*)(ws + WS_CS); float* LUTA = (float*)(ws + WS_LUT); float* LUTD = LUTA + 4 * 257; bf16_t* HB = (bf16_t*)(ws + WS_HB); bf16_t* PROJ = (bf16_t*)(ws + WS_PROJ); bf16_t* UB = (bf16_t*)(ws + WS_PROJ); bf16_t* ACT = (bf16_t*)(ws + WS_ACT); bf16_t* MIX = (bf16_t*)(ws + WS_MIX); bf16_t* DPART = (bf16_t*)(ws + WS_DPART); bf16_t* KR = (bf16_t*)(ws + WS_KR); float* LSEB = (float*)(ws + WS_LSE); float* xout = ap_->out; (void)ws; (void)x_in; (void)c_in; (void)positions; (void)rel_bias; (void)w_mod; (void)b_mod; (void)norm_g; (void)a_sink; (void)b_conv; (void)c_norm_q; (void)c_norm_kv; (void)ffn_conv; (void)MOD; (void)CS; (void)LUTA; (void)LUTD; (void)HB; (void)PROJ; (void)UB; (void)ACT; (void)MIX; (void)DPART; (void)KR; (void)LSEB; (void)xout

    { PHASE_IDS();
    LAS float* sl = (LAS float*)(lds + 65536);
    for (int i = tid; i < 8 * 1024; i += NTHREADS) { const float cv = c_in[i]; sl[i] = cv * __builtin_amdgcn_rcpf(1.f + __builtin_amdgcn_exp2f(-cv * LOG2E)); }
    __syncthreads();
    for (int it = gw; it < DEPTH * 24 * 16; it += NGW) {
        const int l = it / 384, rem = it % 384, cb = rem >> 4, kc = rem & 15;
        const int col = cb * 256 + 4 * lane;
        const float* w = w_mod + ((size_t)l * 1024 + kc * 64) * 6144 + col;
        f32x4 acc[8];
#pragma unroll
        for (int b = 0; b < 8; ++b) acc[b] = (f32x4){0.f, 0.f, 0.f, 0.f};
        for (int k0 = 0; k0 < 64; k0 += 8) {
            f32x4 wv[8];
#pragma unroll
            for (int k = 0; k < 8; ++k) wv[k] = *(const f32x4*)(w + (size_t)(k0 + k) * 6144);
#pragma unroll
            for (int k = 0; k < 8; ++k)
#pragma unroll
                for (int b = 0; b < 8; ++b) acc[b] += wv[k] * sl[b * 1024 + kc * 64 + k0 + k];
        }
        float* MP = (float*)(ws + WS_ACT);
#pragma unroll
        for (int b = 0; b < 8; ++b) *(f32x4*)(MP + (((size_t)l * 16 + kc) * 8 + b) * 6144 + col) = acc[b];
    }
    __syncthreads();
    convert_weights((const float*)ap_->in[7], (const float*)ap_->in[12], (const float*)ap_->in[13], (const float*)ap_->in[14], (const float*)ap_->in[15], (const float*)ap_->in[17], ws, 0, lds, gw, NGW, wave, lane);
    for (int i = gt; i < T * 16; i += NGT) {
        const int row = i >> 4, j = i & 15;
        const float invf = __builtin_amdgcn_exp2f(-(float)j * (13.287712379549449f / 16.f));
        const float ang = (float)positions[row] * invf;
        const double rev = (double)ang * 0.15915494309189535;
        const float fr = (float)(rev - __builtin_rint(rev));
        CS[(size_t)row * 32 + j] = __builtin_amdgcn_cosf(fr);
        CS[(size_t)row * 32 + 16 + j] = __builtin_amdgcn_sinf(fr);
    }
    if (bid == 0) {
        for (int i = tid; i < 4 * 257; i += NTHREADS) { const int hd = i / 257, rel = i % 257 - 128; LUTA[i] = rel_bias[t5_bucket(rel) * 16 + hd] * LOG2E; }
        for (int i = tid; i < 12 * 129; i += NTHREADS) { const int gh = i / 129, ri = i % 129 - 64, g = gh >> 2, hd = gh & 3; const int d = (g == 0) ? 1 : (g == 1 ? 4 : 16);
            LUTD[i] = rel_bias[t5_bucket(ri * d) * 16 + 4 + 4 * g + hd] * LOG2E; }
    }
    }
    GSYNC();
    { PHASE_IDS(); const float* MP = (const float*)(ws + WS_ACT);
      for (int i = gt; i < DEPTH * 8 * 6144; i += NGT) { const int l = i / (8 * 6144), rem = i % (8 * 6144), b = rem / 6144, col = rem % 6144;
          float s = b_mod[l * 6144 + col];
#pragma unroll
          for (int kc = 0; kc < 16; ++kc) s += MP[(((size_t)l * 16 + kc) * 8 + b) * 6144 + col];
          MOD[i] = s; } }
    GSYNC();
    { PHASE_IDS();
    for (int row = 2 * gw; row < T; row += 2 * NGW) {
        const int b = row >> 12; const float* md = MOD + (size_t)b * 6144;
        row_pass<2>(row, 1, x_in, nullptr, nullptr, nullptr, nullptr, norm_g, md + 1024, md, HB, lane);
    } }
    GSYNC();

    for (int l = 0; l < DEPTH; ++l) {
        { PTRS(); pg8::Gemm g{HB, (const bf16_t*)(ws + W_IN), T, NIN, 1024, 1024}; pg8::StaticOrder S; S.init(T, NIN, G, bid);
          pg8::EpiProj E{PROJ}; pg8::gemm_phase<pg8::EpiProj, true>(lds, g, S, E); }
        GSYNC();
        { PHASE_IDS();
        const f32x4 gq = ((const f32x4*)(c_norm_q + l * 256))[lane];
        const f32x2 gk = ((const f32x2*)(c_norm_kv + l * 128))[lane];
        const float* bw = b_conv + (size_t)l * 3 * 256;
        const f32x4 w0 = ((const f32x4*)bw)[lane], w1 = ((const f32x4*)(bw + 256))[lane], w2 = ((const f32x4*)(bw + 512))[lane];
        for (int row0 = 4 * gw; row0 < T; row0 += 4 * NGW) {
            bf16_t* pr = PROJ + (size_t)row0 * PRM;
            const int s0 = row0 & (SEQ - 1);
            u32x2 cqw[4]; unsigned ckw[4]; u32x2 bbw[4]; u32x2 bcw[6], bhw[6];
#pragma unroll
            for (int q = 0; q < 4; ++q) { cqw[q] = ((const u32x2*)(pr + (size_t)q * PRM + 768))[lane]; ckw[q] = ((const unsigned*)(pr + (size_t)q * PRM + 1024))[lane];
                bbw[q] = ((const u32x2*)(pr + (size_t)q * PRM + 0))[lane]; }
#pragma unroll
            for (int k = 0; k < 6; ++k) { const bool ok = (k == 0) ? (s0 > 0) : ((k == 5) ? (s0 + 4 < SEQ) : true);
                bcw[k] = (u32x2){0u, 0u}; bhw[k] = bcw[k];
                if (ok) { bcw[k] = ((const u32x2*)(pr + (ptrdiff_t)(k - 1) * PRM + 256))[lane]; bhw[k] = ((const u32x2*)(pr + (ptrdiff_t)(k - 1) * PRM + 512))[lane]; } }
            const int rq = lane >> 4, ri = lane & 15;
            const float t1 = bf1(pr[(size_t)rq * PRM + 1152 + ri]), t2 = bf1(pr[(size_t)rq * PRM + 1168 + ri]);
            const float cs_ = CS[(size_t)(row0 + rq) * 32 + ri], sn = CS[(size_t)(row0 + rq) * 32 + 16 + ri];
            f32x4 cqv[4]; float kv0[4], kv1[4], ssq[4], ssk[4];
#pragma unroll
            for (int q = 0; q < 4; ++q) { cqv[q] = unpack4(cqw[q]); kv0[q] = bf_lo(ckw[q]); kv1[q] = bf_hi(ckw[q]);
                ssq[q] = (cqv[q][0] * cqv[q][0] + cqv[q][1] * cqv[q][1]) + (cqv[q][2] * cqv[q][2] + cqv[q][3] * cqv[q][3]); ssk[q] = kv0[q] * kv0[q] + kv1[q] * kv1[q]; }
#pragma unroll
            for (int o = 1; o < 64; o <<= 1) {
#pragma unroll
                for (int q = 0; q < 4; ++q) { ssq[q] += __shfl_xor(ssq[q], o); ssk[q] += __shfl_xor(ssk[q], o); } }
#pragma unroll
            for (int q = 0; q < 4; ++q) {
                const float rq_ = rsqrtf(ssq[q] * (1.f / 256.f) + EPS), rk_ = rsqrtf(ssk[q] * (1.f / 128.f) + EPS);
                ((u32x2*)(pr + (size_t)q * PRM + 768))[lane] = pack4(cqv[q] * rq_ * gq);
                ((unsigned*)(pr + (size_t)q * PRM + 1024))[lane] = pk2(kv0[q] * rk_ * gk[0], kv1[q] * rk_ * gk[1]);
            }
            KR[(size_t)(row0 + rq) * 32 + ri] = (bf16_t)(pk2(t1 * cs_ - t2 * sn, 0.f) & 0xffffu);
            KR[(size_t)(row0 + rq) * 32 + 16 + ri] = (bf16_t)(pk2(t2 * cs_ + t1 * sn, 0.f) & 0xffffu);
            f32x4 prod[6];
#pragma unroll
            for (int k = 0; k < 6; ++k) prod[k] = unpack4(bcw[k]) * unpack4(bhw[k]);
#pragma unroll
            for (int q = 0; q < 4; ++q) { const f32x4 ob = unpack4(bbw[q]) * (prod[q] * w0 + prod[q + 1] * w1 + prod[q + 2] * w2);
                ((u32x2*)(MIX + (size_t)(row0 + q) * 1024 + 256))[lane] = pack4(ob); }
        } }
        GSYNC();
        { PTRS(); pg8::Gemm g{PROJ + 768, (const bf16_t*)(ws + W_MLA), T, 1024, 384, PRM}; pg8::StaticOrder S; S.init(T, 1024, G, bid);
          pg8::EpiMla E{HB, 1024, CS, 0.10206207261596575f * LOG2E}; pg8::gemm_phase<pg8::EpiMla, true>(lds, g, S, E); }
        GSYNC();
        { PHASE_IDS();
        if (wave >= 4) __builtin_amdgcn_s_setprio(1);
        for (int ui = bid; ui < 5 * 512; ui += G) {
            const int kind = ui >> 9, idx = ui & 511;
            const int bb = idx >> 6, rem = idx & 63, head = rem >> 4, rr = rem & 15;
            AU u;
            if (kind == 0) {
                const size_t hrow = (size_t)(bb * 4 + head) * SEQ;
                u.Q = HB + hrow * 96; u.qpitch = 96; u.K1 = HB + (size_t)T * 384 + hrow * 64; u.k1pitch = 64; u.K2 = KR + (size_t)bb * SEQ * 32; u.k2pitch = 32;
                u.V = HB + (size_t)T * 640 + hrow * 64; u.vpitch = 64; u.O = MIX + (size_t)bb * SEQ * 1024 + 512 + head * 64; u.opitch = 1024; u.LSE = nullptr; u.lsepitch = 0; u.lut = nullptr;
                u.R = 1 << 20; u.q0 = 256 * rr; u.kt_lo = 0; u.kt_hi = 64; u.sc = 0.10206207261596575f * LOG2E; u.m0 = -1e30f; u.l0 = 0.f;
                attn_unit_c(lds, u, tid, wave, lane);
            } else {
                int Ls;
                if (kind == 1) {
                    const bf16_t* hmb = PROJ + HM_OFF;
                    u.Q = hmb + ((size_t)(bb * 4 + head) * SEQ) * 64; u.qpitch = 64;
                    u.K1 = hmb + (size_t)T * 256 + ((size_t)(bb * 4 + (head >> 1)) * SEQ) * 64; u.k1pitch = 64;
                    u.V = hmb + (size_t)T * 256 + ((size_t)(bb * 4 + 2 + (head >> 1)) * SEQ) * 64; u.vpitch = 64;
                    u.O = MIX + (size_t)bb * SEQ * 1024 + head * 64; u.opitch = 1024; u.LSE = nullptr; u.lsepitch = 0; u.lut = LUTA + head * 257;
                    u.R = 128; u.q0 = 256 * rr; Ls = SEQ; u.m0 = a_sink[l * 4 + head] * LOG2E; u.l0 = 1.f;
                } else {
                    const int g = kind - 2, d = (g == 0) ? 1 : (g == 1 ? 4 : 16);
                    const int res = rr % d, qb = rr / d; Ls = SEQ / d;
                    const size_t brow = (size_t)bb * SEQ + res;
                    { const bf16_t* hmb = PROJ + HM_OFF; const size_t hoff = ((size_t)(bb * 4 + head) * SEQ + (size_t)res * Ls) * 64;
                      u.Q = hmb + (size_t)(2 + 3 * g) * T * 256 + hoff; u.K1 = hmb + (size_t)(3 + 3 * g) * T * 256 + hoff; u.V = hmb + (size_t)(4 + 3 * g) * T * 256 + hoff;
                      u.qpitch = 64; u.k1pitch = 64; u.vpitch = 64; }
                    u.O = DPART + (size_t)g * T * 256 + brow * 256 + head * 64; u.opitch = d * 256; u.LSE = LSEB + (size_t)g * T * 4 + brow * 4 + head; u.lsepitch = 4 * d;
                    u.lut = LUTD + (g * 4 + head) * 129; u.R = 64; u.q0 = 256 * qb; u.m0 = -1e30f; u.l0 = 0.f;
                }
                u.K2 = nullptr; u.k2pitch = 0; u.sc = 0.125f * LOG2E;
                const int lo = (u.q0 - u.R) >> 6, hi = ((u.q0 + 255 + u.R) >> 6) + 1;
                u.kt_lo = lo < 0 ? 0 : lo; u.kt_hi = hi > (Ls >> 6) ? (Ls >> 6) : hi;
                attn_unit_w(lds, u, tid, wave, lane);
            }
        }
        __builtin_amdgcn_s_setprio(0); }
        GSYNC();
        { PHASE_IDS();
        const int hd = lane >> 4;
        for (int row0 = 4 * gw; row0 < T; row0 += 4 * NGW) {
            float lse[4][3]; u32x2 dv[4][3];
#pragma unroll
            for (int q = 0; q < 4; ++q)
#pragma unroll
                for (int g = 0; g < 3; ++g) { lse[q][g] = LSEB[(size_t)g * T * 4 + (size_t)(row0 + q) * 4 + hd]; dv[q][g] = ((const u32x2*)(DPART + (size_t)g * T * 256 + (size_t)(row0 + q) * 256))[lane]; }
#pragma unroll
            for (int q = 0; q < 4; ++q) {
                const float mx = fmaxf(lse[q][0], fmaxf(lse[q][1], lse[q][2]));
                const float e0 = __builtin_amdgcn_exp2f(lse[q][0] - mx), e1 = __builtin_amdgcn_exp2f(lse[q][1] - mx), e2 = __builtin_amdgcn_exp2f(lse[q][2] - mx);
                const float inv = 1.f / (e0 + e1 + e2);
                const f32x4 od = (unpack4(dv[q][0]) * e0 + unpack4(dv[q][1]) * e1 + unpack4(dv[q][2]) * e2) * inv;
                ((u32x2*)(MIX + (size_t)(row0 + q) * 1024 + 768))[lane] = pack4(od);
            }
        } }
        GSYNC();
        { PTRS(); pg8::Gemm g{MIX, (const bf16_t*)(ws + W_OUT), T, 1024, 1024, 1024}; pg8::StaticOrder S; S.init(T, 1024, G, bid);
          pg8::EpiBf16 E{HB, 1024}; pg8::gemm_phase<pg8::EpiBf16, true>(lds, g, S, E); }
        GSYNC();
        { PHASE_IDS(); const float* MODl = MOD + (size_t)l * 8 * 6144; const float* ng = norm_g + (size_t)l * 4 * 1024;
        for (int row = 4 * gw; row < T; row += 4 * NGW) {
            const int b = row >> 12; const float* md = MODl + (size_t)b * 6144;
            if (l == 0) row_pass<4, false, true>(row, 1, x_in, HB, md + 2048, ng + 1024, (float*)(ws + WS_PROJ + 16 * MiB), ng + 2048, md + 4096, md + 3072, HB, lane);
            else row_pass<4, true, true>(row, 1, (const float*)((const bf16_t*)xout + (size_t)T * DM), HB, md + 2048, ng + 1024, (float*)(ws + WS_PROJ + 16 * MiB), ng + 2048, md + 4096, md + 3072, HB, lane);
        } }
        GSYNC();
        { PTRS(); pg8::Gemm g{HB, (const bf16_t*)(ws + W_UP), T, 2 * DFF, 1024, 1024}; pg8::StaticOrder S; S.init(T, 2 * DFF, G, bid);
          pg8::EpiConv E{ACT, (float*)(ws + WS_PROJ), ffn_conv + (size_t)l * 3 * 5632}; pg8::gemm_phase<pg8::EpiConv, true>(lds, g, S, E); }
        GSYNC();
        { PHASE_IDS();
          pg8::StaticOrder S; S.init(T, 1024, G, bid); pg8::Unit uu;
          const float* UH = (const float*)(ws + WS_PROJ);
          const float* fw = ffn_conv + (size_t)l * 3 * 5632;
          for (int i = 0; S.next(i, uu); ++i) {
              const int pm = uu.pm;
              if (tid < 352) {
                  const int c = 8 * tid, tile = c >> 7, within = c & 127, gcol = 256 * tile + within;
                  float wg[3][8], wv[3][8];
#pragma unroll
                  for (int t3 = 0; t3 < 3; ++t3) { const f32x4 a0 = *(const f32x4*)(fw + t3 * 5632 + c), a1 = *(const f32x4*)(fw + t3 * 5632 + c + 4);
                      const f32x4 b0 = *(const f32x4*)(fw + t3 * 5632 + 2816 + c), b1 = *(const f32x4*)(fw + t3 * 5632 + 2816 + c + 4);
#pragma unroll
                      for (int e = 0; e < 4; ++e) { wg[t3][e] = a0[e]; wg[t3][4 + e] = a1[e]; wv[t3][e] = b0[e]; wv[t3][4 + e] = b1[e]; } }
#pragma unroll
                  for (int which = 0; which < 2; ++which) {
                      const int row = 256 * pm + (which ? 255 : 0), s = row & (SEQ - 1);
                      const float* up_p = which ? UH + ((size_t)pm * 4 + 2) * 5632 : UH + ((size_t)(pm - 1) * 4 + 3) * 5632;
                      const bool up_ok = which ? true : (s != 0);
                      const float* cur_p = UH + ((size_t)pm * 4 + (which ? 3 : 0)) * 5632;
                      const float* dn_p = which ? UH + ((size_t)(pm + 1) * 4) * 5632 : UH + ((size_t)pm * 4 + 1) * 5632;
                      const bool dn_ok = which ? (s != SEQ - 1) : true;
                      float ug[8], uv[8];
#pragma unroll
                      for (int hf = 0; hf < 2; ++hf) {
                          const f32x4 z = {0.f, 0.f, 0.f, 0.f};
                          const f32x4 gu = up_ok ? *(const f32x4*)(up_p + gcol + 4 * hf) : z, vu = up_ok ? *(const f32x4*)(up_p + gcol + 128 + 4 * hf) : z;
                          const f32x4 gc = *(const f32x4*)(cur_p + gcol + 4 * hf), vc = *(const f32x4*)(cur_p + gcol + 128 + 4 * hf);
                          const f32x4 gd = dn_ok ? *(const f32x4*)(dn_p + gcol + 4 * hf) : z, vd = dn_ok ? *(const f32x4*)(dn_p + gcol + 128 + 4 * hf) : z;
#pragma unroll
                          for (int e = 0; e < 4; ++e) { const int k = 4 * hf + e;
                              ug[k] = wg[0][k] * gu[e] + wg[1][k] * gc[e] + wg[2][k] * gd[e];
                              uv[k] = wv[0][k] * vu[e] + wv[1][k] * vc[e] + wv[2][k] * vd[e]; }
                      }
                      u32x4 ow;
#pragma unroll
                      for (int e2 = 0; e2 < 4; ++e2) ow[e2] = pk2(gelu_tanh(ug[2 * e2]) * uv[2 * e2], gelu_tanh(ug[2 * e2 + 1]) * uv[2 * e2 + 1]);
                      *(u32x4*)(ACT + (size_t)row * DFF + c) = ow;
                  }
              }
          }
          asm volatile("s_waitcnt vmcnt(0)" ::: "memory"); __syncthreads();
        }
        { PTRS(); pg8::Gemm g{ACT, (const bf16_t*)(ws + W_DOWN), T, 1024, DFF, DFF}; pg8::StaticOrder S; S.init(T, 1024, G, bid);
          pg8::EpiBf16 E{HB, 1024}; pg8::gemm_phase<pg8::EpiBf16, true>(lds, g, S, E); }
        GSYNC();
        { PHASE_IDS(); const float* MODl = MOD + (size_t)l * 8 * 6144; const float* ng = norm_g + (size_t)l * 4 * 1024;
            const bool lastl = (l == DEPTH - 1);
            const float* MODn = MOD + (size_t)(lastl ? l : l + 1) * 8 * 6144;
            const float* ngn = norm_g + (size_t)(lastl ? l : l + 1) * 4 * 1024;
            for (int row = 4 * gw; row < T; row += 4 * NGW) {
                const int b = row >> 12; const float* md = MODl + (size_t)b * 6144; const float* mdn = MODn + (size_t)b * 6144;
                if (lastl) row_pass<4, true, false>(row, 1, (const float*)(ws + WS_PROJ + 16 * MiB), HB, md + 5120, ng + 3072, xout, ngn, mdn + 1024, mdn, nullptr, lane);
                else row_pass<4, true, true>(row, 1, (const float*)(ws + WS_PROJ + 16 * MiB), HB, md + 5120, ng + 3072, (float*)((bf16_t*)xout + (size_t)T * DM), ngn, mdn + 1024, mdn, HB, lane);
            }
            if (!lastl) convert_weights((const float*)ap_->in[7], (const float*)ap_->in[12], (const float*)ap_->in[13], (const float*)ap_->in[14], (const float*)ap_->in[15], (const float*)ap_->in[17], ws, l + 1, lds, gw, NGW, wave, lane);
        }
        if (l + 1 < DEPTH) GSYNC();
    }
}

extern "C" void kernel_launch(void* const* d_in, const int* in_sizes, int n_in, void* d_out, int out_size, void* d_ws, size_t ws_size, hipStream_t stream) {
    static int grid = 0;
    if (grid == 0) {
        if (n_in != 18 || ws_size < WS_END) { fprintf(stderr, "kernel_launch: unexpected n_in %d / ws_size %zu (need %zu)\n", n_in, ws_size, (size_t)WS_END); grid = -1; return; }
        int dev = 0, cus = 0;
        hipGetDevice(&dev); hipDeviceGetAttribute(&cus, hipDeviceAttributeMultiprocessorCount, dev);
        if (hipFuncSetAttribute((const void*)mega, hipFuncAttributeMaxDynamicSharedMemorySize, LDS_BYTES) != hipSuccess) { fprintf(stderr, "hipFuncSetAttribute failed\n"); grid = -1; return; }
        grid = cus > 0 ? cus : 256;
    }
    if (grid < 0) return;
    hipMemsetAsync(d_ws, 0, XCD_BAR_WORDS * 4, stream);
    Args a{};
    for (int i = 0; i < 18; ++i) a.in[i] = d_in[i];
    a.out = (float*)d_out; a.ws = (unsigned char*)d_ws;
    void* args[] = {&a};
    hipError_t e = hipLaunchCooperativeKernel((const void*)mega, dim3(grid), dim3(NTHREADS), args, LDS_BYTES, stream);
    if (e != hipSuccess) fprintf(stderr, "cooperative launch failed: %s (grid %d)\n", hipGetErrorString(e), grid);
}
```

```cpp
#include <hip/hip_runtime.h>
#include <hip/hip_cooperative_groups.h>
#include <cstdio>
#include <cstdint>
namespace cg = cooperative_groups;

#define LAS __attribute__((address_space(3)))
typedef unsigned short bf16_t;
typedef short bf16x8 __attribute__((ext_vector_type(8)));
typedef short s16x4 __attribute__((ext_vector_type(4)));
typedef float f32x4 __attribute__((ext_vector_type(4)));
typedef float f32x2 __attribute__((ext_vector_type(2)));
typedef float f32x16 __attribute__((ext_vector_type(16)));
typedef unsigned u32x4 __attribute__((ext_vector_type(4)));
typedef unsigned u32x2 __attribute__((ext_vector_type(2)));
typedef __bf16 bf16x2_t __attribute__((ext_vector_type(2)));

constexpr int NB = 8, SEQ = 4096, T = NB * SEQ, DM = 1024, NIN = 4096, DFF = 2816, DEPTH = 4;
constexpr int NTHREADS = 512, NWAVES = 8;
constexpr float EPS = 1e-6f, LOG2E = 1.4426950408889634f;
constexpr int PRM = 1280;
constexpr size_t HM_OFF = (size_t)T * PRM;
constexpr int UP0 = 1536, UP1 = 1280, ULD = 3072;

constexpr size_t MiB = 1u << 20;
constexpr size_t WS_MOD = 1 * MiB;
constexpr size_t MOD_BYTES = (size_t)DEPTH * NB * 6144 * 4;
constexpr size_t WS_CS = 2 * MiB;
constexpr size_t WS_LUT = 6 * MiB;
constexpr size_t WS_W = 8 * MiB;
constexpr size_t W_IN = WS_W, W_MLA = WS_W + 8 * MiB, W_OUT = WS_W + 9 * MiB, W_UP = WS_W + 11 * MiB, W_DOWN = WS_W + 22 * MiB;
constexpr size_t WS_HB = 36 * MiB;
constexpr size_t WS_PROJ = 100 * MiB;
constexpr size_t WS_ACT = 292 * MiB;
constexpr size_t WS_MIX = 356 * MiB;
constexpr size_t WS_DPART = 420 * MiB;
constexpr size_t WS_KR = 468 * MiB;
constexpr size_t WS_LSE = 470 * MiB;
constexpr size_t WS_END = 472 * MiB;

constexpr int LDS_BYTES = 131072 + 1024 + 8192;
constexpr int LDS_XB = 131072 + 1024;

__device__ __forceinline__ unsigned pk2(float lo, float hi) { f32x2 v = {lo, hi}; bf16x2_t b = __builtin_convertvector(v, bf16x2_t); return __builtin_bit_cast(unsigned, b); }
__device__ __forceinline__ float bf_lo(unsigned w) { return __uint_as_float(w << 16); }
__device__ __forceinline__ float bf_hi(unsigned w) { return __uint_as_float(w & 0xffff0000u); }
__device__ __forceinline__ float bf1(bf16_t w) { return __uint_as_float(((unsigned)w) << 16); }
__device__ __forceinline__ float wave_sum(float v) {
#pragma unroll
    for (int o = 1; o < 64; o <<= 1) v += __shfl_xor(v, o);
    return v;
}
__device__ __forceinline__ float max3f(float a, float b, float c) { float r; asm("v_max3_f32 %0, %1, %2, %3" : "=v"(r) : "v"(a), "v"(b), "v"(c)); return r; }
__device__ __forceinline__ float max2f(float a, float b) { float r; asm("v_max_f32_e32 %0, %1, %2" : "=v"(r) : "v"(a), "v"(b)); return r; }
__device__ __forceinline__ f32x4 unpack4(u32x2 w) { return (f32x4){bf_lo(w.x), bf_hi(w.x), bf_lo(w.y), bf_hi(w.y)}; }
__device__ __forceinline__ u32x2 pack4(f32x4 v) { u32x2 w; w.x = pk2(v[0], v[1]); w.y = pk2(v[2], v[3]); return w; }

__device__ __forceinline__ float gelu_tanh(float x) {
    const float t = x + 0.044715f * x * x * x;
    const float e = __builtin_amdgcn_exp2f(-2.f * 0.7978845608028654f * LOG2E * t);
    return x * __builtin_amdgcn_rcpf(1.f + e);
}
namespace pg8 {
constexpr int BM = 256, BK = 64, HALF = 128, HTB = HALF * BK * 2, STAGE_BYTES = 8 * HTB, NXCD = 8, WGM = 8;
__host__ __device__ __forceinline__ int lds_byte(int r, int c) { const int st = (r >> 4) * 2 + (c >> 5), rr = r & 15, cc = c & 31, ob = rr * 64 + cc * 2; return st * 1024 + (ob ^ (((ob >> 9) & 1) << 5)); }
__host__ __device__ __forceinline__ void stage_rc(int b, int& R, int& C) { const int st = b / 1024, sb = b % 1024, swz = sb ^ (((sb >> 9) & 1) << 5); R = (st >> 1) * 16 + swz / 64; C = (st & 1) * 32 + (swz % 64) / 2; }
__host__ __device__ __forceinline__ int perm32(int rho) { const int n = rho >> 4, i = rho & 15; return 8 * (i >> 2) + 4 * n + (i & 3); }

struct Unit { int pm, pn; };
struct Gemm { const bf16_t* A; const bf16_t* Bt; int M, N, K, lda; };

struct StaticOrder {
    int nM, nN, nwg, G, c;
    __device__ __forceinline__ void init(int M, int N, int G_, int c_) { nM = M / BM; nN = N / BM; nwg = nM * nN; G = G_; c = c_; }
    __device__ __forceinline__ bool next(int i, Unit& u) const {
        const long L = (long)i * G + c; if (L >= nwg) return false;
        int wgid = (int)L; { const int q = nwg / NXCD, r = nwg % NXCD, xcd = wgid % NXCD, off = wgid / NXCD; wgid = (xcd < r ? xcd * (q + 1) : r * (q + 1) + (xcd - r) * q) + off; }
        const int nig = WGM * nN, gid = wgid / nig, fm = gid * WGM, gsz = (nM - fm) < WGM ? (nM - fm) : WGM;
        u.pm = fm + ((wgid % nig) % gsz); u.pn = (wgid % nig) / gsz; return true;
    }
};

struct EpiBf16 {
    static constexpr bool PERM = true, NEEDS_LDS = false;
    bf16_t* O; int ldc;
    __device__ __forceinline__ void operator()(const f32x4 (&acc)[2][2][4][2], const Unit& u, int wr, int wc, int fr, int fq) const {
        const int row0 = u.pm * BM + wr * 64 + fr; const int col0 = u.pn * BM + wc * 32 + 8 * fq;
#pragma unroll
        for (int ai = 0; ai < 2; ++ai)
#pragma unroll
            for (int m = 0; m < 4; ++m) { bf16_t* rowp = O + (size_t)(row0 + ai * HALF + m * 16) * ldc + col0;
#pragma unroll
                for (int bj = 0; bj < 2; ++bj) { const f32x4 v0 = acc[ai][bj][m][0], v1 = acc[ai][bj][m][1];
                    u32x4 w; w.x = pk2(v0[0], v0[1]); w.y = pk2(v0[2], v0[3]); w.z = pk2(v1[0], v1[1]); w.w = pk2(v1[2], v1[3]);
                    *(u32x4*)(rowp + bj * HALF) = w; } }
    }
};
struct EpiProj {
    static constexpr bool PERM = true, NEEDS_LDS = false;
    bf16_t* O;
    __device__ __forceinline__ void operator()(const f32x4 (&acc)[2][2][4][2], const Unit& u, int wr, int wc, int fr, int fq) const {
        const int row0 = u.pm * BM + wr * 64 + fr; const int pn = u.pn;
        const bool rm = (pn >= 2 && pn <= 6);
        const int hm = pn < 2 ? pn : pn - 5;
        const int gsel = pn < 7 ? 0 : (pn - 7) / 3;
        const int dsh = gsel == 0 ? 0 : (gsel == 1 ? 2 : 4);
#pragma unroll
        for (int ai = 0; ai < 2; ++ai)
#pragma unroll
            for (int m = 0; m < 4; ++m) {
                const int row = row0 + ai * HALF + m * 16;
                const int b = row >> 12, s = row & (SEQ - 1);
                const int sp = ((s & ((1 << dsh) - 1)) << (12 - dsh)) + (s >> dsh);
#pragma unroll
                for (int bj = 0; bj < 2; ++bj) { const f32x4 v0 = acc[ai][bj][m][0], v1 = acc[ai][bj][m][1];
                    u32x4 w; w.x = pk2(v0[0], v0[1]); w.y = pk2(v0[2], v0[3]); w.z = pk2(v1[0], v1[1]); w.w = pk2(v1[2], v1[3]);
                    const int c = bj * HALF + wc * 32 + 8 * fq;
                    bf16_t* dst = rm ? O + (size_t)row * PRM + (pn - 2) * 256 + c
                                     : O + HM_OFF + (size_t)hm * T * 256 + ((size_t)(b * 4 + (c >> 6)) * SEQ + sp) * 64 + (c & 63);
                    *(u32x4*)dst = w; }
            }
    }
};
struct EpiMla {
    static constexpr bool PERM = false, NEEDS_LDS = false;
    bf16_t* O; int ldc; const float* cs; float qs;
    __device__ __forceinline__ void operator()(const f32x4 (&acc)[2][2][4][2], const Unit& u, int wr, int wc, int fr, int fq) const {
        const int row0 = u.pm * BM + wr * 64 + fr;
#pragma unroll
        for (int bj = 0; bj < 2; ++bj) {
            const int cgp = u.pn * 8 + bj * 4 + wc;
            const bool rope = (cgp < 12) && ((cgp % 3) == 2);
            const int col0 = cgp * 32 + 4 * fq;
#pragma unroll
            for (int ai = 0; ai < 2; ++ai)
#pragma unroll
                for (int m = 0; m < 4; ++m) {
                    const int row = row0 + ai * HALF + m * 16;
                    f32x4 v0 = acc[ai][bj][m][0], v1 = acc[ai][bj][m][1];
                    if (rope) {
                        const f32x4 c = *(const f32x4*)(cs + (size_t)row * 32 + 4 * fq), s = *(const f32x4*)(cs + (size_t)row * 32 + 16 + 4 * fq);
                        const f32x4 a = v0 * c - v1 * s, b = v1 * c + v0 * s; v0 = a; v1 = b;
                    }
                    if (cgp < 12) { v0 = v0 * qs; v1 = v1 * qs; }
                    const int bq = row >> 12, sq = row & (SEQ - 1);
                    bf16_t* rowp;
                    if (cgp < 12) rowp = O + ((size_t)(bq * 4 + cgp / 3) * SEQ + sq) * 96 + (cgp % 3) * 32 + 4 * fq;
                    else if (cgp < 20) rowp = O + (size_t)T * 384 + ((size_t)(bq * 4 + (cgp - 12) / 2) * SEQ + sq) * 64 + ((cgp - 12) & 1) * 32 + 4 * fq;
                    else rowp = O + (size_t)T * 640 + ((size_t)(bq * 4 + (cgp - 20) / 2) * SEQ + sq) * 64 + ((cgp - 20) & 1) * 32 + 4 * fq;
                    if (cgp < 28) { *(u32x2*)(rowp) = pack4(v0); *(u32x2*)(rowp + 16) = pack4(v1); }
                }
        }
    }
};

#define DPP_ROR1 0x121
#define DPP_ROR15 0x12F
#define DPP_SHR1 0x111
#define DPP_SHL1 0x101
__device__ __forceinline__ float dppf(float old, float src, const int ctrl_sel) {
    int r;
    if (ctrl_sel == 0) r = __builtin_amdgcn_update_dpp(__float_as_int(old), __float_as_int(src), DPP_ROR1, 0xf, 0xf, false);
    else if (ctrl_sel == 1) r = __builtin_amdgcn_update_dpp(__float_as_int(old), __float_as_int(src), DPP_ROR15, 0xf, 0xf, false);
    else if (ctrl_sel == 2) r = __builtin_amdgcn_update_dpp(__float_as_int(old), __float_as_int(src), DPP_SHR1, 0xf, 0xf, false);
    else r = __builtin_amdgcn_update_dpp(__float_as_int(old), __float_as_int(src), DPP_SHL1, 0xf, 0xf, false);
    return __int_as_float(r);
}
struct EpiConv {
    static constexpr bool PERM = true, NEEDS_LDS = true;
    bf16_t* ACTp; float* UH; const float* fw;
    __device__ __forceinline__ void operator()(const f32x4 (&acc)[2][2][4][2], const Unit& u, int wr, int wc, int fr, int fq, LAS unsigned char* lds) const {
        LAS float* XB = (LAS float*)(lds + LDS_XB);
        const int chl = wc * 32 + 8 * fq;
        const int ch = u.pn * 128 + chl;
#pragma unroll
        for (int ai = 0; ai < 2; ++ai) {
            const int blk = 2 * ai + wr;
#pragma unroll
            for (int bj = 0; bj < 2; ++bj)
#pragma unroll
                for (int n = 0; n < 2; ++n) {
                    if (fr == 0) *(LAS f32x4*)(XB + (2 * blk) * 256 + bj * 128 + chl + 4 * n) = acc[ai][bj][0][n];
                    if (fr == 15) *(LAS f32x4*)(XB + (2 * blk + 1) * 256 + bj * 128 + chl + 4 * n) = acc[ai][bj][3][n];
                }
        }
        float wg[3][8], wv[3][8];
#pragma unroll
        for (int t3 = 0; t3 < 3; ++t3) { const f32x4 a0 = *(const f32x4*)(fw + t3 * 5632 + ch), a1 = *(const f32x4*)(fw + t3 * 5632 + ch + 4);
            const f32x4 b0 = *(const f32x4*)(fw + t3 * 5632 + 2816 + ch), b1 = *(const f32x4*)(fw + t3 * 5632 + 2816 + ch + 4);
#pragma unroll
            for (int e = 0; e < 4; ++e) { wg[t3][e] = a0[e]; wg[t3][4 + e] = a1[e]; wv[t3][e] = b0[e]; wv[t3][4 + e] = b1[e]; } }
        asm volatile("s_waitcnt lgkmcnt(0)" ::: "memory"); __builtin_amdgcn_s_barrier(); asm volatile("" ::: "memory");
        {
            float* uh = UH + (size_t)u.pm * 4 * 5632 + u.pn * 256 + chl;
            if (wr == 0 && fr < 2) {
#pragma unroll
                for (int bj = 0; bj < 2; ++bj)
#pragma unroll
                    for (int n = 0; n < 2; ++n) *(f32x4*)(uh + (size_t)fr * 5632 + bj * 128 + 4 * n) = acc[0][bj][0][n];
            }
            if (wr == 1 && fr >= 14) {
#pragma unroll
                for (int bj = 0; bj < 2; ++bj)
#pragma unroll
                    for (int n = 0; n < 2; ++n) *(f32x4*)(uh + (size_t)(fr - 12) * 5632 + bj * 128 + 4 * n) = acc[1][bj][3][n];
            }
        }
#pragma unroll
        for (int ai = 0; ai < 2; ++ai) {
            const int blk = 2 * ai + wr;
#pragma unroll
            for (int m = 0; m < 4; ++m) {
                const int trow = 64 * blk + 16 * m + fr;
                float og[8], ov[8];
#pragma unroll
                for (int bj = 0; bj < 2; ++bj)
#pragma unroll
                    for (int n = 0; n < 2; ++n) {
                        f32x4 pv, nv;
                        if (m == 0) pv = (blk > 0) ? *(const LAS f32x4*)(XB + (2 * blk - 1) * 256 + bj * 128 + chl + 4 * n) : (f32x4){0.f, 0.f, 0.f, 0.f};
                        if (m == 3) nv = (blk < 3) ? *(const LAS f32x4*)(XB + (2 * blk + 2) * 256 + bj * 128 + chl + 4 * n) : (f32x4){0.f, 0.f, 0.f, 0.f};
#pragma unroll
                        for (int e = 0; e < 4; ++e) {
                            const float cur = acc[ai][bj][m][n][e];
                            const float upB = (m == 0) ? pv[e] : dppf(0.f, acc[ai][bj][m == 0 ? 0 : m - 1][n][e], 0);
                            const float dnB = (m == 3) ? nv[e] : dppf(0.f, acc[ai][bj][m == 3 ? 3 : m + 1][n][e], 1);
                            const float up = dppf(upB, cur, 2), dn = dppf(dnB, cur, 3);
                            const int k = 4 * n + e;
                            if (bj == 0) og[k] = wg[0][k] * up + wg[1][k] * cur + wg[2][k] * dn;
                            else         ov[k] = wv[0][k] * up + wv[1][k] * cur + wv[2][k] * dn;
                        }
                    }
                u32x4 ow;
#pragma unroll
                for (int e2 = 0; e2 < 4; ++e2) ow[e2] = pk2(gelu_tanh(og[2 * e2]) * ov[2 * e2], gelu_tanh(og[2 * e2 + 1]) * ov[2 * e2 + 1]);
                if (trow != 0 && trow != 255) *(u32x4*)(ACTp + (size_t)(u.pm * BM + trow) * DFF + ch) = ow;
            }
        }
    }
};

template <class Epi, bool ALIGN_EPI>
__device__ __forceinline__ void gemm_phase(LAS unsigned char* lds, const Gemm g, const StaticOrder& S, const Epi& E) {
    int tid = threadIdx.x; asm volatile("" : "+v"(tid));
    const int wid = __builtin_amdgcn_readfirstlane(tid >> 6), lane = tid & 63, wr = wid >> 2, wc = wid & 3, fr = lane & 15, fq = lane >> 4;
    const int K = g.K, nt = K / BK, lda = g.lda;
    unsigned voffA[2], voffB[2];
#pragma unroll
    for (int i = 0; i < 2; ++i) { int R, C; stage_rc(tid * 16 + i * 8192, R, C); const int Rb = Epi::PERM ? ((R & ~31) + perm32(R & 31)) : R;
        voffA[i] = (unsigned)(R * lda + C) * 2u; voffB[i] = (unsigned)(Rb * K + C) * 2u; }
    const size_t kstep = (size_t)(BK * 2);
    const size_t hstepA = (size_t)HALF * lda * 2, hstepB = (size_t)HALF * K * 2;
    const size_t tstepA = 2 * hstepA, tstepB = 2 * hstepB;
    const unsigned ldsw = (unsigned)wid * 1024u;
    const int aoff = lds_byte(wr * 64 + fr, fq * 8), boff = lds_byte(wc * 32 + fr, fq * 8);
#define PG8_SA(b, h) (((b) * 2 + (h)) * HTB)
#define PG8_SB(b, h) ((4 + (b) * 2 + (h)) * HTB)
#define PG8_STAGE(bufoff, gbase, voff) do { _Pragma("unroll") for (int _i = 0; _i < 2; ++_i) \
        __builtin_amdgcn_global_load_lds((const unsigned*)((const char*)(gbase) + (voff)[_i]), (LAS unsigned*)(lds + (bufoff) + ldsw + _i * 8192), 16, 0, 0); } while (0)
#define PG8_LDA(dst, b, h) do { _Pragma("unroll") for (int m = 0; m < 4; ++m) _Pragma("unroll") for (int k = 0; k < 2; ++k) dst[m][k] = *(const LAS bf16x8*)(lds + PG8_SA(b, h) + aoff + m * 2048 + k * 1024); } while (0)
#define PG8_LDB(dst, b, h) do { _Pragma("unroll") for (int n = 0; n < 2; ++n) _Pragma("unroll") for (int k = 0; k < 2; ++k) dst[n][k] = *(const LAS bf16x8*)(lds + PG8_SB(b, h) + boff + n * 2048 + k * 1024); } while (0)
#define PG8_MMA(ai, bj, At, Bt) do { __builtin_amdgcn_s_setprio(1); _Pragma("unroll") for (int m = 0; m < 4; ++m) _Pragma("unroll") for (int n = 0; n < 2; ++n) _Pragma("unroll") for (int k = 0; k < 2; ++k) \
        acc[ai][bj][m][n] = __builtin_amdgcn_mfma_f32_16x16x32_bf16(Bt[n][k], At[m][k], acc[ai][bj][m][n], 0, 0, 0); __builtin_amdgcn_s_setprio(0); } while (0)
#define PG8_WAIT_V(n) asm volatile("s_waitcnt vmcnt(" #n ")" ::: "memory")
#define PG8_WAIT_L(n) asm volatile("s_waitcnt lgkmcnt(" #n ")" ::: "memory")
#define PG8_BAR __builtin_amdgcn_s_barrier()
#define PG8_SCHED __builtin_amdgcn_sched_barrier(0)
    Unit cur, nxt; int ui = 0;
    if (!S.next(0, cur)) return;
    f32x4 acc[2][2][4][2];
#pragma unroll
    for (int a = 0; a < 2; ++a)
#pragma unroll
        for (int b = 0; b < 2; ++b)
#pragma unroll
            for (int m = 0; m < 4; ++m)
#pragma unroll
                for (int n = 0; n < 2; ++n) acc[a][b][m][n] = (f32x4){0.f, 0.f, 0.f, 0.f};
    bf16x8 At[4][2], B0[2][2], B1[2][2];
    const char* cA = (const char*)g.A + (size_t)cur.pm * tstepA; const char* cB = (const char*)g.Bt + (size_t)cur.pn * tstepB;
    PG8_STAGE(PG8_SB(0, 0), cB, voffB); PG8_STAGE(PG8_SB(0, 1), cB + hstepB, voffB); PG8_STAGE(PG8_SA(0, 0), cA, voffA); PG8_STAGE(PG8_SA(0, 1), cA + hstepA, voffA);
    if (wr == 1) PG8_BAR;
    PG8_WAIT_V(2); PG8_BAR;
    PG8_STAGE(PG8_SB(1, 0), cB + kstep, voffB); PG8_STAGE(PG8_SA(1, 0), cA + kstep, voffA); PG8_STAGE(PG8_SB(1, 1), cB + hstepB + kstep, voffB);
    PG8_WAIT_V(6); PG8_BAR;
    for (;;) {
        const bool has_next = S.next(ui + 1, nxt);
        const char* nA = has_next ? (const char*)g.A + (size_t)nxt.pm * tstepA : cA; const char* nB = has_next ? (const char*)g.Bt + (size_t)nxt.pn * tstepB : cB;
#pragma unroll 1
        for (int t = 0; t < nt; t += 2) {
            const bool last = (t == nt - 2);
            const char* a1 = cA + (size_t)(t + 1) * kstep;
            const char* a2 = last ? nA : cA + (size_t)(t + 2) * kstep; const char* b2 = last ? nB : cB + (size_t)(t + 2) * kstep;
            const char* a3 = a2 + kstep; const char* b3 = b2 + kstep;
            PG8_LDB(B0, 0, 0); PG8_LDB(B1, 0, 1); PG8_SCHED; PG8_LDA(At, 0, 0); PG8_STAGE(PG8_SA(1, 1), a1 + hstepA, voffA);
            PG8_WAIT_V(8); PG8_WAIT_L(0); PG8_BAR; PG8_MMA(0, 0, At, B0); PG8_MMA(0, 1, At, B1); PG8_BAR; PG8_SCHED;
            PG8_LDA(At, 0, 1); PG8_STAGE(PG8_SB(0, 0), b2, voffB); PG8_STAGE(PG8_SB(0, 1), b2 + hstepB, voffB); PG8_STAGE(PG8_SA(0, 0), a2, voffA);
            PG8_WAIT_V(8); PG8_WAIT_L(0); PG8_BAR; PG8_MMA(1, 0, At, B0); PG8_MMA(1, 1, At, B1); PG8_BAR; PG8_SCHED;
            PG8_LDB(B0, 1, 0); PG8_LDB(B1, 1, 1); PG8_SCHED; PG8_LDA(At, 1, 0); PG8_STAGE(PG8_SA(0, 1), a2 + hstepA, voffA);
            PG8_WAIT_V(8); PG8_WAIT_L(0); PG8_BAR; PG8_MMA(0, 0, At, B0); PG8_MMA(0, 1, At, B1); PG8_BAR; PG8_SCHED;
            PG8_LDA(At, 1, 1); PG8_STAGE(PG8_SB(1, 0), b3, voffB); PG8_STAGE(PG8_SB(1, 1), b3 + hstepB, voffB); PG8_STAGE(PG8_SA(1, 0), a3, voffA);
            PG8_WAIT_V(8); PG8_WAIT_L(0); PG8_BAR; PG8_MMA(1, 0, At, B0); PG8_MMA(1, 1, At, B1); PG8_BAR; PG8_SCHED;
        }
        if constexpr (ALIGN_EPI) { if (wr == 0) PG8_BAR; }
        if constexpr (Epi::NEEDS_LDS) E(acc, cur, wr, wc, fr, fq, lds); else E(acc, cur, wr, wc, fr, fq);
        if (!has_next) break;
#pragma unroll
        for (int a = 0; a < 2; ++a)
#pragma unroll
            for (int b = 0; b < 2; ++b)
#pragma unroll
                for (int m = 0; m < 4; ++m)
#pragma unroll
                    for (int n = 0; n < 2; ++n) acc[a][b][m][n] = (f32x4){0.f, 0.f, 0.f, 0.f};
        cur = nxt; cA = nA; cB = nB; ++ui;
        if constexpr (ALIGN_EPI) { if (wr == 1) PG8_BAR; }
    }
    PG8_WAIT_V(0);
    if constexpr (!ALIGN_EPI) { if (wr == 0) PG8_BAR; }
    PG8_BAR;
#undef PG8_SA
#undef PG8_SB
#undef PG8_STAGE
#undef PG8_LDA
#undef PG8_LDB
#undef PG8_MMA
#undef PG8_WAIT_V
#undef PG8_WAIT_L
#undef PG8_BAR
#undef PG8_SCHED
}
}

__device__ __forceinline__ void store_row_t21(bf16_t* ob, const f32x16& o0, const f32x16& o1, float inv, int h) {
#pragma unroll
    for (int db = 0; db < 2; ++db)
#pragma unroll
        for (int gp = 0; gp < 2; ++gp) {
            const int g0 = 2 * gp, g1 = 2 * gp + 1;
            u32x2 a, b;
            if (db == 0) { a.x = pk2(o0[4 * g0] * inv, o0[4 * g0 + 1] * inv); a.y = pk2(o0[4 * g0 + 2] * inv, o0[4 * g0 + 3] * inv);
                           b.x = pk2(o0[4 * g1] * inv, o0[4 * g1 + 1] * inv); b.y = pk2(o0[4 * g1 + 2] * inv, o0[4 * g1 + 3] * inv); }
            else         { a.x = pk2(o1[4 * g0] * inv, o1[4 * g0 + 1] * inv); a.y = pk2(o1[4 * g0 + 2] * inv, o1[4 * g0 + 3] * inv);
                           b.x = pk2(o1[4 * g1] * inv, o1[4 * g1 + 1] * inv); b.y = pk2(o1[4 * g1 + 2] * inv, o1[4 * g1 + 3] * inv); }
            { auto r = __builtin_amdgcn_permlane32_swap(a.x, b.x, false, false); a.x = r[0]; b.x = r[1]; }
            { auto r = __builtin_amdgcn_permlane32_swap(a.y, b.y, false, false); a.y = r[0]; b.y = r[1]; }
            u32x4 w; w.x = a.x; w.y = a.y; w.z = b.x; w.w = b.y;
            *(u32x4*)(ob + 32 * db + 16 * gp + 8 * h) = w;
        }
}
struct AU {
    const bf16_t* Q; const bf16_t* K1; const bf16_t* K2; const bf16_t* V; bf16_t* O; float* LSE; const float* lut;
    int qpitch, k1pitch, k2pitch, vpitch, opitch, lsepitch;
    int R, q0, kt_lo, kt_hi;
    float sc, m0, l0;
};
constexpr int AT_KBUF = 64 * 208, AT_VBUF = 64 * 192, AT_LUT = 2 * AT_KBUF + 2 * AT_VBUF, AT_PAD = 128;

template <int DK, bool BANDED>
__device__ __forceinline__ void attn_unit(LAS unsigned char* lds, const AU& u, int tid, int wid, int lane) {
    constexpr int KP = DK * 2 + 16, VP = 192, NKS = DK / 16;
    const int r = lane & 31, h = lane >> 5;
    const int qidx = u.q0 + 32 * wid + r;
    LAS float* lut = (LAS float*)(lds + AT_LUT);
    if (BANDED) { for (int i = tid; i < 2 * u.R + 1 + 2 * AT_PAD; i += NTHREADS) { const int j = i - AT_PAD; lut[i] = (j >= 0 && j <= 2 * u.R) ? u.lut[j] : -1e30f; } }
    bf16x8 qf[NKS];
    { const bf16_t* qp = u.Q + (size_t)qidx * u.qpitch + 8 * h;
#pragma unroll
      for (int ks = 0; ks < NKS; ++ks) qf[ks] = *(const bf16x8*)(qp + 16 * ks); }
    float m = u.m0, l = u.l0;
    f32x16 o0, o1;
#pragma unroll
    for (int i = 0; i < 16; ++i) { o0[i] = 0.f; o1[i] = 0.f; }
    const int skey = tid >> 3, sch = tid & 7, skey2 = tid >> 2, sch2 = tid & 3;
    u32x4 kreg, vreg, k2reg = {0u, 0u, 0u, 0u};
#define AT_LOAD(kt_) do { const size_t key_ = (size_t)(64 * (kt_) + skey); \
        kreg = *(const u32x4*)(u.K1 + key_ * u.k1pitch + 8 * sch); vreg = *(const u32x4*)(u.V + key_ * u.vpitch + 8 * sch); \
        if (DK == 96 && tid < 256) k2reg = *(const u32x4*)(u.K2 + (size_t)(64 * (kt_) + skey2) * u.k2pitch + 8 * sch2); } while (0)
    const int qlo = u.q0 + 32 * wid, qhi = qlo + 31;
    AT_LOAD(u.kt_lo);
    for (int kt = u.kt_lo; kt < u.kt_hi; ++kt) {
        const int buf = (kt - u.kt_lo) & 1;
        LAS unsigned char* Kb = lds + buf * AT_KBUF; LAS unsigned char* Vb = lds + 2 * AT_KBUF + buf * AT_VBUF;
        *(LAS u32x4*)(Kb + skey * KP + 16 * sch) = kreg;
        *(LAS u32x4*)(Vb + skey * VP + 16 * sch) = vreg;
        if (DK == 96 && tid < 256) *(LAS u32x4*)(Kb + skey2 * KP + 128 + 16 * sch2) = k2reg;
        __syncthreads();
        if (kt + 1 < u.kt_hi) AT_LOAD(kt + 1);
        const bool active = !BANDED || ((64 * kt + 63 >= qlo - u.R) && (64 * kt <= qhi + u.R));
        if (active) {
            f32x16 p0, p1;
#pragma unroll
            for (int i = 0; i < 16; ++i) { p0[i] = 0.f; p1[i] = 0.f; }
#pragma unroll
            for (int ks = 0; ks < NKS; ++ks) {
                const bf16x8 a0 = *(const LAS bf16x8*)(Kb + r * KP + (16 * ks + 8 * h) * 2);
                const bf16x8 a1 = *(const LAS bf16x8*)(Kb + (32 + r) * KP + (16 * ks + 8 * h) * 2);
                p0 = __builtin_amdgcn_mfma_f32_32x32x16_bf16(a0, qf[ks], p0, 0, 0, 0);
                p1 = __builtin_amdgcn_mfma_f32_32x32x16_bf16(a1, qf[ks], p1, 0, 0, 0);
            }
            __builtin_amdgcn_sched_barrier(0);
            float mx = -1e30f;
            const LAS float* lb = lut + (64 * kt + 4 * h - qidx + u.R + AT_PAD);
#pragma unroll
            for (int i = 0; i < 16; ++i) {
                float s0 = p0[i] * u.sc, s1 = p1[i] * u.sc;
                if (BANDED) { s0 += lb[(i & 3) + 8 * (i >> 2)]; s1 += lb[32 + (i & 3) + 8 * (i >> 2)]; }
                p0[i] = s0; p1[i] = s1; mx = fmaxf(mx, fmaxf(s0, s1));
            }
            mx = fmaxf(mx, __shfl_xor(mx, 32));
            const float mn = fmaxf(m, mx), alpha = __builtin_amdgcn_exp2f(m - mn); m = mn;
            float rs = 0.f;
#pragma unroll
            for (int i = 0; i < 16; ++i) { p0[i] = __builtin_amdgcn_exp2f(p0[i] - mn); p1[i] = __builtin_amdgcn_exp2f(p1[i] - mn); rs += p0[i] + p1[i]; }
            rs += __shfl_xor(rs, 32);
            l = l * alpha + rs;
#pragma unroll
            for (int i = 0; i < 16; ++i) { o0[i] *= alpha; o1[i] *= alpha; }
            __builtin_amdgcn_sched_barrier(0);
            const int trow = 4 * h + ((lane & 15) >> 2), tcol = (16 * ((lane >> 4) & 1) + 4 * (lane & 3)) * 2;
#pragma unroll
            for (int hf = 0; hf < 2; ++hf)
#pragma unroll
                for (int s = 0; s < 2; ++s) {
                    u32x4 xw;
                    if (hf == 0) { xw.x = pk2(p0[8 * s], p0[8 * s + 1]); xw.y = pk2(p0[8 * s + 2], p0[8 * s + 3]); xw.z = pk2(p0[8 * s + 4], p0[8 * s + 5]); xw.w = pk2(p0[8 * s + 6], p0[8 * s + 7]); }
                    else         { xw.x = pk2(p1[8 * s], p1[8 * s + 1]); xw.y = pk2(p1[8 * s + 2], p1[8 * s + 3]); xw.z = pk2(p1[8 * s + 4], p1[8 * s + 5]); xw.w = pk2(p1[8 * s + 6], p1[8 * s + 7]); }
                    const bf16x8 xs = __builtin_bit_cast(bf16x8, xw);
                    const LAS unsigned char* vp = Vb + (32 * hf + 16 * s + trow) * VP + tcol;
                    const s16x4 lo0 = __builtin_bit_cast(s16x4, __builtin_amdgcn_ds_read_tr16_b64_v4i16((LAS s16x4*)(vp)));
                    const s16x4 hi0 = __builtin_bit_cast(s16x4, __builtin_amdgcn_ds_read_tr16_b64_v4i16((LAS s16x4*)(vp + 8 * VP)));
                    const s16x4 lo1 = __builtin_bit_cast(s16x4, __builtin_amdgcn_ds_read_tr16_b64_v4i16((LAS s16x4*)(vp + 64)));
                    const s16x4 hi1 = __builtin_bit_cast(s16x4, __builtin_amdgcn_ds_read_tr16_b64_v4i16((LAS s16x4*)(vp + 8 * VP + 64)));
                    const bf16x8 pa0 = __builtin_shufflevector(lo0, hi0, 0, 1, 2, 3, 4, 5, 6, 7);
                    const bf16x8 pa1 = __builtin_shufflevector(lo1, hi1, 0, 1, 2, 3, 4, 5, 6, 7);
                    o0 = __builtin_amdgcn_mfma_f32_32x32x16_bf16(pa0, xs, o0, 0, 0, 0);
                    o1 = __builtin_amdgcn_mfma_f32_32x32x16_bf16(pa1, xs, o1, 0, 0, 0);
                }
        }
    }
#undef AT_LOAD
    {
        const float inv = 1.f / l;
        bf16_t* op = u.O + (size_t)qidx * u.opitch + 4 * h;
#pragma unroll
        for (int g = 0; g < 4; ++g) {
            u32x2 w0, w1;
            w0.x = pk2(o0[4 * g] * inv, o0[4 * g + 1] * inv); w0.y = pk2(o0[4 * g + 2] * inv, o0[4 * g + 3] * inv);
            w1.x = pk2(o1[4 * g] * inv, o1[4 * g + 1] * inv); w1.y = pk2(o1[4 * g + 2] * inv, o1[4 * g + 3] * inv);
            *(u32x2*)(op + 8 * g) = w0; *(u32x2*)(op + 32 + 8 * g) = w1;
        }
        if (u.LSE && h == 0) u.LSE[(size_t)qidx * u.lsepitch] = m + __builtin_amdgcn_logf(l);
    }
    __syncthreads();
}


constexpr int AC_KP = 208, AC_VP = 192, AC_KBUF = 64 * AC_KP, AC_VBUF = 64 * AC_VP, AC_VOFF = 2 * AC_KBUF;
__device__ __forceinline__ void attn_unit_c(LAS unsigned char* lds, const AU& u, int tid, int wid, int lane) {
    constexpr int NT = SEQ / 64;
    const int r = lane & 31, h = lane >> 5;
    const int qidx = u.q0 + 32 * wid + r;
    bf16x8 qf[6];
    { const bf16_t* qp = u.Q + (size_t)qidx * u.qpitch + 8 * h;
#pragma unroll
      for (int ks = 0; ks < 6; ++ks) qf[ks] = *(const bf16x8*)(qp + 16 * ks); }
    float m = -1e30f, l = 0.f;
    f32x16 o0, o1;
#pragma unroll
    for (int i = 0; i < 16; ++i) { o0[i] = 0.f; o1[i] = 0.f; }
    const int skey = tid >> 3, sch = tid & 7, skey2 = tid >> 2, sch2 = tid & 3;
    u32x4 kreg, vreg, k2reg = {0u, 0u, 0u, 0u};
    const bf16_t* kp1 = u.K1 + (size_t)skey * u.k1pitch + 8 * sch;
    const bf16_t* vp1 = u.V + (size_t)skey * u.vpitch + 8 * sch;
    const bf16_t* kp2 = u.K2 + (size_t)skey2 * u.k2pitch + 8 * sch2;
#define AC_LOAD(kt_) do { kreg = *(const u32x4*)(kp1 + (size_t)(64 * (kt_)) * u.k1pitch); vreg = *(const u32x4*)(vp1 + (size_t)(64 * (kt_)) * u.vpitch); \
        if (tid < 256) k2reg = *(const u32x4*)(kp2 + (size_t)(64 * (kt_)) * u.k2pitch); } while (0)
#define AC_STORE(kt_) do { LAS unsigned char* Kb_ = lds + ((kt_) & 1) * AC_KBUF; LAS unsigned char* Vb_ = lds + AC_VOFF + ((kt_) % 3) * AC_VBUF; \
        *(LAS u32x4*)(Kb_ + skey * AC_KP + 16 * sch) = kreg; *(LAS u32x4*)(Vb_ + skey * AC_VP + 16 * sch) = vreg; \
        if (tid < 256) *(LAS u32x4*)(Kb_ + skey2 * AC_KP + 128 + 16 * sch2) = k2reg; } while (0)
#define AC_QK(P0, P1, kt_) do { const LAS unsigned char* Kb_ = lds + ((kt_) & 1) * AC_KBUF + r * AC_KP + 16 * h; \
        bf16x8 ka_[6], kb_[6]; \
        _Pragma("unroll") for (int ks = 0; ks < 6; ++ks) { ka_[ks] = *(const LAS bf16x8*)(Kb_ + 32 * ks); kb_[ks] = *(const LAS bf16x8*)(Kb_ + 32 * AC_KP + 32 * ks); } \
        _Pragma("unroll") for (int i_ = 0; i_ < 16; ++i_) { P0[i_] = negm; P1[i_] = negm; } \
        _Pragma("unroll") for (int ks = 0; ks < 6; ++ks) { \
            P0 = __builtin_amdgcn_mfma_f32_32x32x16_bf16(ka_[ks], qf[ks], P0, 0, 0, 0); P1 = __builtin_amdgcn_mfma_f32_32x32x16_bf16(kb_[ks], qf[ks], P1, 0, 0, 0); } } while (0)
    const int trow = 4 * h + ((lane & 15) >> 2), tcol = (16 * ((lane >> 4) & 1) + 4 * (lane & 3)) * 2;
#define AC_SOFTMAX_PV(P0, P1, N0, N1, kt_) do { \
          \
        float rq_[4] = {0.f, 0.f, 0.f, 0.f}; int mq_[4];     \
        _Pragma("unroll") for (int i_ = 0; i_ < 16; ++i_) { P0[i_] = __builtin_amdgcn_exp2f(P0[i_]); P1[i_] = __builtin_amdgcn_exp2f(P1[i_]); rq_[i_ & 3] += P0[i_] + P1[i_]; \
            if (i_ < 4) mq_[i_] = max(__float_as_int(P0[i_]), __float_as_int(P1[i_])); else mq_[i_ & 3] = max(max(mq_[i_ & 3], __float_as_int(P0[i_])), __float_as_int(P1[i_])); } \
        const LAS unsigned char* Vb_ = lds + AC_VOFF + ((kt_) % 3) * AC_VBUF + trow * AC_VP + tcol; \
        s16x4 vl0_[4], vh0_[4], vl1_[4], vh1_[4]; \
        _Pragma("unroll") for (int q_ = 0; q_ < 4; ++q_) { const LAS unsigned char* vp_ = Vb_ + (16 * q_) * AC_VP; \
            vl0_[q_] = __builtin_bit_cast(s16x4, __builtin_amdgcn_ds_read_tr16_b64_v4i16((LAS s16x4*)(vp_))); \
            vh0_[q_] = __builtin_bit_cast(s16x4, __builtin_amdgcn_ds_read_tr16_b64_v4i16((LAS s16x4*)(vp_ + 8 * AC_VP))); \
            vl1_[q_] = __builtin_bit_cast(s16x4, __builtin_amdgcn_ds_read_tr16_b64_v4i16((LAS s16x4*)(vp_ + 64))); \
            vh1_[q_] = __builtin_bit_cast(s16x4, __builtin_amdgcn_ds_read_tr16_b64_v4i16((LAS s16x4*)(vp_ + 8 * AC_VP + 64))); } \
        _Pragma("unroll") for (int hf = 0; hf < 2; ++hf) _Pragma("unroll") for (int s = 0; s < 2; ++s) { \
            u32x4 xw_; \
            if (hf == 0) { xw_.x = pk2(P0[8 * s], P0[8 * s + 1]); xw_.y = pk2(P0[8 * s + 2], P0[8 * s + 3]); xw_.z = pk2(P0[8 * s + 4], P0[8 * s + 5]); xw_.w = pk2(P0[8 * s + 6], P0[8 * s + 7]); } \
            else         { xw_.x = pk2(P1[8 * s], P1[8 * s + 1]); xw_.y = pk2(P1[8 * s + 2], P1[8 * s + 3]); xw_.z = pk2(P1[8 * s + 4], P1[8 * s + 5]); xw_.w = pk2(P1[8 * s + 6], P1[8 * s + 7]); } \
            const bf16x8 xs_ = __builtin_bit_cast(bf16x8, xw_); \
            o0 = __builtin_amdgcn_mfma_f32_32x32x16_bf16(__builtin_shufflevector(vl0_[2 * hf + s], vh0_[2 * hf + s], 0, 1, 2, 3, 4, 5, 6, 7), xs_, o0, 0, 0, 0); \
            o1 = __builtin_amdgcn_mfma_f32_32x32x16_bf16(__builtin_shufflevector(vl1_[2 * hf + s], vh1_[2 * hf + s], 0, 1, 2, 3, 4, 5, 6, 7), xs_, o1, 0, 0, 0); } \
        float rs_ = (rq_[0] + rq_[1]) + (rq_[2] + rq_[3]); \
        rs_ += __shfl_xor(rs_, 32); l += rs_; \
        int emi_ = max(max(max(mq_[0], mq_[1]), mq_[2]), mq_[3]); \
        emi_ = max(emi_, __shfl_xor(emi_, 32)); \
        const float em_ = __int_as_float(emi_); \
        if ((kt_) == 0 || __builtin_amdgcn_ballot_w64(em_ > 256.0f) != 0ull) { \
            const float ec_ = (kt_) == 0 ? fmaxf(em_, 1e-30f) : fmaxf(em_, 1.f); \
            const float dl_ = __builtin_amdgcn_logf(ec_), al_ = __builtin_amdgcn_exp2f(-dl_); l *= al_; \
            _Pragma("unroll") for (int i_ = 0; i_ < 16; ++i_) { o0[i_] *= al_; o1[i_] *= al_; N0[i_] -= dl_; N1[i_] -= dl_; } negm -= dl_; } } while (0)
    f32x16 pA0, pA1, pB0, pB1; float negm = 0.f;
#pragma unroll
    for (int i = 0; i < 16; ++i) { pB0[i] = 0.f; pB1[i] = 0.f; }
    AC_LOAD(0); AC_STORE(0);
    __syncthreads();
    AC_LOAD(1);
    AC_QK(pA0, pA1, 0);
    for (int t = 0; t < NT; t += 2) {
        AC_STORE(t + 1);
        __syncthreads();
        if (t + 2 < NT) AC_LOAD(t + 2);
        AC_QK(pB0, pB1, t + 1);
        AC_SOFTMAX_PV(pA0, pA1, pB0, pB1, t);
        if (t + 2 < NT) AC_STORE(t + 2);
        __syncthreads();
        if (t + 3 < NT) AC_LOAD(t + 3);
        if (t + 2 < NT) AC_QK(pA0, pA1, t + 2);
        AC_SOFTMAX_PV(pB0, pB1, pA0, pA1, t + 1);
    }
#undef AC_LOAD
#undef AC_STORE
#undef AC_QK
#undef AC_SOFTMAX_PV
    {
        const float inv = 1.f / l;
        store_row_t21(u.O + (size_t)qidx * u.opitch, o0, o1, inv, h);
    }
    __syncthreads();
}

constexpr int BW_VP = 192, BW_VBYTES = 64 * BW_VP, BW_LUT = 8 * BW_VBYTES;
__device__ __forceinline__ void attn_unit_w(LAS unsigned char* lds, const AU& u, int tid, int wid, int lane) {
    const int r = lane & 31, h = lane >> 5;
    const int qidx = u.q0 + 32 * wid + r;
    LAS float* lut = (LAS float*)(lds + BW_LUT);
    for (int i = tid; i < 2 * u.R + 1 + 2 * AT_PAD; i += NTHREADS) { const int j = i - AT_PAD; lut[i] = (j >= 0 && j <= 2 * u.R) ? u.lut[j] : -1e30f; }
    bf16x8 qf[4];
    { const bf16_t* qp = u.Q + (size_t)qidx * u.qpitch + 8 * h;
#pragma unroll
      for (int ks = 0; ks < 4; ++ks) qf[ks] = *(const bf16x8*)(qp + 16 * ks); }
    float m = u.m0, l = u.l0;
    f32x16 o0, o1;
#pragma unroll
    for (int i = 0; i < 16; ++i) { o0[i] = 0.f; o1[i] = 0.f; }
    const int qlo = u.q0 + 32 * wid;
    int t_lo = (qlo - u.R) >> 6, t_hi = ((qlo + 31 + u.R) >> 6) + 1;
    t_lo = t_lo < u.kt_lo ? u.kt_lo : t_lo; t_hi = t_hi > u.kt_hi ? u.kt_hi : t_hi;
    LAS unsigned char* Vw = lds + wid * BW_VBYTES;
    const int vkey = lane >> 3, vch = lane & 7;
    bf16x8 kf[8]; u32x4 vr[8];
    const bf16_t* kbase = u.K1 + (size_t)r * u.k1pitch + 8 * h;
    const bf16_t* vbase = u.V + (size_t)vkey * u.vpitch + 8 * vch;
#define BW_LOAD(t_) do { const bf16_t* kp_ = kbase + (size_t)(64 * (t_)) * u.k1pitch; const bf16_t* vp_ = vbase + (size_t)(64 * (t_)) * u.vpitch; \
        _Pragma("unroll") for (int ks = 0; ks < 4; ++ks) { kf[ks] = *(const bf16x8*)(kp_ + 16 * ks); kf[4 + ks] = *(const bf16x8*)(kp_ + (size_t)32 * u.k1pitch + 16 * ks); } \
        _Pragma("unroll") for (int j = 0; j < 8; ++j) vr[j] = *(const u32x4*)(vp_ + (size_t)(8 * j) * u.vpitch); } while (0)
    __syncthreads();
    if (t_lo < t_hi) BW_LOAD(t_lo);
    const int trow = 4 * h + ((lane & 15) >> 2), tcol = (16 * ((lane >> 4) & 1) + 4 * (lane & 3)) * 2;
    for (int kt = t_lo; kt < t_hi; ++kt) {
#pragma unroll
        for (int j = 0; j < 8; ++j) *(LAS u32x4*)(Vw + (vkey + 8 * j) * BW_VP + 16 * vch) = vr[j];
        bf16x8 kc[8];
#pragma unroll
        for (int i = 0; i < 8; ++i) kc[i] = kf[i];
        if (kt + 1 < t_hi) BW_LOAD(kt + 1);
        f32x16 p0, p1;
#pragma unroll
        for (int i = 0; i < 16; ++i) { p0[i] = 0.f; p1[i] = 0.f; }
#pragma unroll
        for (int ks = 0; ks < 4; ++ks) {
            p0 = __builtin_amdgcn_mfma_f32_32x32x16_bf16(kc[ks], qf[ks], p0, 0, 0, 0);
            p1 = __builtin_amdgcn_mfma_f32_32x32x16_bf16(kc[4 + ks], qf[ks], p1, 0, 0, 0);
        }
        const LAS float* lb = lut + (64 * kt + 4 * h - qidx + u.R + AT_PAD);
        float mq[4] = {-1e30f, -1e30f, -1e30f, -1e30f};
#pragma unroll
        for (int i = 0; i < 16; ++i) {
            const float s0 = p0[i] * u.sc + lb[(i & 3) + 8 * (i >> 2)], s1 = p1[i] * u.sc + lb[32 + (i & 3) + 8 * (i >> 2)];
            p0[i] = s0; p1[i] = s1; mq[i & 3] = max3f(mq[i & 3], s0, s1);
        }
        float mx = max2f(max3f(mq[0], mq[1], mq[2]), mq[3]);
        mx = max2f(mx, __shfl_xor(mx, 32));
        if (__builtin_amdgcn_ballot_w64(mx > m + 8.0f) != 0ull) {
            const float mn = fmaxf(m, mx), alpha = __builtin_amdgcn_exp2f(m - mn); m = mn; l *= alpha;
#pragma unroll
            for (int i = 0; i < 16; ++i) { o0[i] *= alpha; o1[i] *= alpha; }
        }
        float rq[4] = {0.f, 0.f, 0.f, 0.f};
#pragma unroll
        for (int i = 0; i < 16; ++i) { p0[i] = __builtin_amdgcn_exp2f(p0[i] - m); p1[i] = __builtin_amdgcn_exp2f(p1[i] - m); rq[i & 3] += p0[i] + p1[i]; }
        float rs = (rq[0] + rq[1]) + (rq[2] + rq[3]);
        rs += __shfl_xor(rs, 32);
        l += rs;
#pragma unroll
        for (int hf = 0; hf < 2; ++hf)
#pragma unroll
            for (int s = 0; s < 2; ++s) {
                u32x4 xw;
                if (hf == 0) { xw.x = pk2(p0[8 * s], p0[8 * s + 1]); xw.y = pk2(p0[8 * s + 2], p0[8 * s + 3]); xw.z = pk2(p0[8 * s + 4], p0[8 * s + 5]); xw.w = pk2(p0[8 * s + 6], p0[8 * s + 7]); }
                else         { xw.x = pk2(p1[8 * s], p1[8 * s + 1]); xw.y = pk2(p1[8 * s + 2], p1[8 * s + 3]); xw.z = pk2(p1[8 * s + 4], p1[8 * s + 5]); xw.w = pk2(p1[8 * s + 6], p1[8 * s + 7]); }
                const bf16x8 xs = __builtin_bit_cast(bf16x8, xw);
                const LAS unsigned char* vp = Vw + (32 * hf + 16 * s + trow) * BW_VP + tcol;
                const s16x4 lo0 = __builtin_bit_cast(s16x4, __builtin_amdgcn_ds_read_tr16_b64_v4i16((LAS s16x4*)(vp)));
                const s16x4 hi0 = __builtin_bit_cast(s16x4, __builtin_amdgcn_ds_read_tr16_b64_v4i16((LAS s16x4*)(vp + 8 * BW_VP)));
                const s16x4 lo1 = __builtin_bit_cast(s16x4, __builtin_amdgcn_ds_read_tr16_b64_v4i16((LAS s16x4*)(vp + 64)));
                const s16x4 hi1 = __builtin_bit_cast(s16x4, __builtin_amdgcn_ds_read_tr16_b64_v4i16((LAS s16x4*)(vp + 8 * BW_VP + 64)));
                o0 = __builtin_amdgcn_mfma_f32_32x32x16_bf16(__builtin_shufflevector(lo0, hi0, 0, 1, 2, 3, 4, 5, 6, 7), xs, o0, 0, 0, 0);
                o1 = __builtin_amdgcn_mfma_f32_32x32x16_bf16(__builtin_shufflevector(lo1, hi1, 0, 1, 2, 3, 4, 5, 6, 7), xs, o1, 0, 0, 0);
            }
    }
#undef BW_LOAD
    {
        int qidx2 = u.q0 + 32 * wid + r; asm volatile("" : "+v"(qidx2));
        const float inv = 1.f / l;
        store_row_t21(u.O + (size_t)qidx2 * u.opitch, o0, o1, inv, h);
        if (u.LSE && h == 0) u.LSE[(size_t)qidx2 * u.lsepitch] = m + __builtin_amdgcn_logf(l);
    }
    __syncthreads();
}

struct Args { const void* in[18]; float* out; unsigned char* ws; };

__device__ __forceinline__ void tr_item(const float* W, int ldw, int k0, int n0, bf16_t* D, int ldd, int drow0, int dk0, LAS float* scr, int lane) {
    if (W) {
        float tv_[32];
#pragma unroll
        for (int i = 0; i < 32; ++i) { const int kk = 2 * i + (lane >> 5); tv_[i] = W[(size_t)(k0 + kk) * ldw + n0 + (lane & 31)]; }
#pragma unroll
        for (int i = 0; i < 32; ++i) { const int kk = 2 * i + (lane >> 5); scr[kk * 33 + (lane & 31)] = tv_[i]; }
    }
    asm volatile("s_waitcnt lgkmcnt(0)" ::: "memory");
    const int c = lane & 7;
#pragma unroll
    for (int j = 0; j < 4; ++j) { const int n = (lane >> 3) + 8 * j; const LAS float* s = scr + (8 * c) * 33 + n;
        unsigned z_ = 0u; asm volatile("" : "+v"(z_)); u32x4 o = {z_, z_, z_, z_};
        if (W) { o.x = pk2(s[0 * 33], s[1 * 33]); o.y = pk2(s[2 * 33], s[3 * 33]); o.z = pk2(s[4 * 33], s[5 * 33]); o.w = pk2(s[6 * 33], s[7 * 33]); }
        *(u32x4*)(D + (size_t)(drow0 + n) * ldd + dk0 + 8 * c) = o; }
    asm volatile("s_waitcnt lgkmcnt(0)" ::: "memory");
}

__device__ __forceinline__ void convert_weights(const float* w_in_, const float* w_uq_, const float* w_ukv_, const float* w_out_, const float* w_up_, const float* w_down_, unsigned char* ws_, int l, LAS unsigned char* lds, int gw, int NGW, int wave, int lane) {
    LAS float* scr = (LAS float*)(lds + wave * 16384);
    unsigned char* ws = ws_;
    const float* w_in = w_in_ + (size_t)l * 1024 * 4000;
    const float* w_uq = w_uq_ + (size_t)l * 256 * 384;
    const float* w_ukv = w_ukv_ + (size_t)l * 128 * 512;
    const float* w_out = w_out_ + (size_t)l * 1024 * 1024;
    const float* w_up = w_up_ + (size_t)l * 1024 * 5632;
    const float* w_down = w_down_ + (size_t)l * 2816 * 1024;
    constexpr int I_IN = 16 * 125, I_OUT = 16 * 32, I_UP = 16 * 176, I_DOWN = 44 * 32, I_MLA = 6 * 32;
    constexpr int NIT = I_IN + I_OUT + I_UP + I_DOWN + I_MLA;
    for (int it = gw; it < NIT; it += NGW) {
        int r = it;
        if (r < I_UP) { const int kb = r / 176, nb = r % 176; const int n0 = 32 * nb;
            int drow; { const int c = n0 < 2816 ? n0 : n0 - 2816; drow = 256 * (c >> 7) + (c & 127) + (n0 < 2816 ? 0 : 128); }
            tr_item(w_up, 5632, 64 * kb, n0, (bf16_t*)(ws + W_UP), 1024, drow, 64 * kb, scr, lane); continue; } r -= I_UP;
        if (r < I_IN) { const int kb = r / 125, nb = r % 125; tr_item(w_in, 4000, 64 * kb, 32 * nb, (bf16_t*)(ws + W_IN), 1024, 32 * nb + (32 * nb >= 1696 ? 96 : 0), 64 * kb, scr, lane); continue; } r -= I_IN;
        if (r < I_DOWN) { const int kb = r / 32, nb = r % 32; tr_item(w_down, 1024, 64 * kb, 32 * nb, (bf16_t*)(ws + W_DOWN), 2816, 32 * nb, 64 * kb, scr, lane); continue; } r -= I_DOWN;
        if (r < I_OUT) { const int kb = r / 32, nb = r % 32; tr_item(w_out, 1024, 64 * kb, 32 * nb, (bf16_t*)(ws + W_OUT), 1024, 32 * nb, 64 * kb, scr, lane); continue; } r -= I_OUT;
        { const int kb = r / 32, nb = r % 32, n0 = 32 * nb; const float* W = nullptr; int ldw = 0, k0 = 0, sn0 = 0;
          if (n0 < 384) { if (kb < 4) { W = w_uq; ldw = 384; k0 = 64 * kb; sn0 = n0; } }
          else if (n0 < 896) { if (kb >= 4) { W = w_ukv; ldw = 512; k0 = 64 * (kb - 4);
                  if (n0 < 640) { const int hk = (n0 - 384) / 64, e0 = (n0 - 384) % 64; sn0 = hk * 128 + e0; } else { const int hv = (n0 - 640) / 64, e0 = (n0 - 640) % 64; sn0 = hv * 128 + 64 + e0; } } }
          tr_item(W, ldw, k0, sn0, (bf16_t*)(ws + W_MLA), 384, n0, 64 * kb, scr, lane); }
    }
}

template <int NR, bool XIN16 = false, bool XOUT16 = false>
__device__ __forceinline__ void row_pass(int row, int rstride, const float* xin, const bf16_t* y, const float* gate, const float* gainY, float* xout,
                                         const float* gainH, const float* sc, const float* sh, bf16_t* hout, int lane) {
    f32x4 xv[NR][4]; f32x4 yv[NR][4];
#pragma unroll
    for (int q = 0; q < NR; ++q) {
        if (XIN16) { const u32x2* xr = (const u32x2*)((const bf16_t*)xin + (size_t)(row + q * rstride) * DM) + lane;
#pragma unroll
            for (int j = 0; j < 4; ++j) xv[q][j] = unpack4(xr[64 * j]); }
        else { const f32x4* xr = (const f32x4*)(xin + (size_t)(row + q * rstride) * DM) + lane;
#pragma unroll
            for (int j = 0; j < 4; ++j) xv[q][j] = xr[64 * j]; } }
    if (y) {
#pragma unroll
        for (int q = 0; q < NR; ++q) { const u32x2* yr = (const u32x2*)(y + (size_t)(row + q * rstride) * DM) + lane;
#pragma unroll
            for (int j = 0; j < 4; ++j) yv[q][j] = unpack4(yr[64 * j]); }
        f32x4 g[4], gy[4];
#pragma unroll
        for (int j = 0; j < 4; ++j) { g[j] = ((const f32x4*)gate)[lane + 64 * j]; gy[j] = ((const f32x4*)gainY)[lane + 64 * j]; }
        float ss[NR];
#pragma unroll
        for (int q = 0; q < NR; ++q) { ss[q] = 0.f;
#pragma unroll
            for (int j = 0; j < 4; ++j) ss[q] += (yv[q][j][0] * yv[q][j][0] + yv[q][j][1] * yv[q][j][1]) + (yv[q][j][2] * yv[q][j][2] + yv[q][j][3] * yv[q][j][3]); }
#pragma unroll
        for (int o = 1; o < 64; o <<= 1) {
#pragma unroll
            for (int q = 0; q < NR; ++q) ss[q] += __shfl_xor(ss[q], o); }
#pragma unroll
        for (int q = 0; q < NR; ++q) { const float rstd = rsqrtf(ss[q] * (1.f / DM) + EPS);
            if (XOUT16) { u32x2* xo = (u32x2*)((bf16_t*)xout + (size_t)(row + q * rstride) * DM) + lane;
#pragma unroll
                for (int j = 0; j < 4; ++j) { xv[q][j] = xv[q][j] + g[j] * (yv[q][j] * rstd * gy[j]); xo[64 * j] = pack4(xv[q][j]); xv[q][j] = unpack4(pack4(xv[q][j])); } }
            else { f32x4* xo = (f32x4*)(xout + (size_t)(row + q * rstride) * DM) + lane;
#pragma unroll
                for (int j = 0; j < 4; ++j) { xv[q][j] = xv[q][j] + g[j] * (yv[q][j] * rstd * gy[j]); xo[64 * j] = xv[q][j]; } } }
    }
    if (hout) {
        f32x4 gh[4], s1[4], s0[4];
#pragma unroll
        for (int j = 0; j < 4; ++j) { gh[j] = ((const f32x4*)gainH)[lane + 64 * j]; s1[j] = ((const f32x4*)sc)[lane + 64 * j]; s0[j] = ((const f32x4*)sh)[lane + 64 * j]; }
        float ss[NR];
#pragma unroll
        for (int q = 0; q < NR; ++q) { ss[q] = 0.f;
#pragma unroll
            for (int j = 0; j < 4; ++j) ss[q] += (xv[q][j][0] * xv[q][j][0] + xv[q][j][1] * xv[q][j][1]) + (xv[q][j][2] * xv[q][j][2] + xv[q][j][3] * xv[q][j][3]); }
#pragma unroll
        for (int o = 1; o < 64; o <<= 1) {
#pragma unroll
            for (int q = 0; q < NR; ++q) ss[q] += __shfl_xor(ss[q], o); }
#pragma unroll
        for (int q = 0; q < NR; ++q) { const float rstd = rsqrtf(ss[q] * (1.f / DM) + EPS);
            u32x2* ho = (u32x2*)(hout + (size_t)(row + q * rstride) * DM) + lane;
#pragma unroll
            for (int j = 0; j < 4; ++j) { const f32x4 hv = (xv[q][j] * rstd * gh[j]) * (1.f + s1[j]) + s0[j]; ho[64 * j] = pack4(hv); } }
    }
}

__device__ __forceinline__ int t5_bucket(int rel) {
    const int n = rel < 0 ? -rel : rel;
    int v;
    if (n < 8) v = n; else { int lg = 8 + (int)(__builtin_amdgcn_logf((float)n * 0.125f) * (8.f / 7.f)); v = lg < 15 ? lg : 15; }
    return (rel > 0 ? 16 : 0) + v;
}


#define XB_TMO      128
#define XB_XCNT(j)  (256  + 64 * (j))
#define XB_XSUB(j)  (1280 + 64 * (j))
#define XB_XGEN(j)  (2304 + 64 * (j))
#define XB_TOP      3328
#define XB_TOPGEN   3392
#define XCD_BAR_WORDS 3456
#define XB_SPIN_CAP (1u << 22)
__device__ __forceinline__ unsigned xb_ld(unsigned* p)              { return __hip_atomic_load(p, __ATOMIC_RELAXED, __HIP_MEMORY_SCOPE_AGENT); }
__device__ __forceinline__ unsigned xb_add(unsigned* p, unsigned v) { return __hip_atomic_fetch_add(p, v, __ATOMIC_RELAXED, __HIP_MEMORY_SCOPE_AGENT); }
__device__ __forceinline__ unsigned xb_xcc_id() { return (unsigned)__builtin_amdgcn_s_getreg((3 << 11) | 20) & 0xFu; }
#define XB_SPIN(cond, bar) do { unsigned _sp = 0; while (cond) { __builtin_amdgcn_s_sleep(1); \
    if ((++_sp & 255u) == 0u) { if (xb_ld(&(bar)[XB_TMO])) break; if (_sp > XB_SPIN_CAP) { atomicAdd(&(bar)[XB_TMO], 1u); break; } } } } while (0)
__device__ __forceinline__ void xcd_barrier_complete(unsigned* bar, unsigned x, unsigned& nloc, unsigned& nx) {
    const unsigned G = gridDim.x;
    unsigned sum, cnt, mine, sp = 0u;
    for (;;) {
        sum = 0u; cnt = 0u; mine = 0u;
#pragma unroll
        for (unsigned j = 0; j < 16; ++j) { const unsigned c = xb_ld(&bar[XB_XCNT(j)]); sum += c; cnt += (c > 0u) ? 1u : 0u; mine = (j == x) ? c : mine; }
        if (sum == G) break;
        __builtin_amdgcn_s_sleep(1);
        if ((++sp & 255u) == 0u) { if (xb_ld(&bar[XB_TMO])) break; if (sp > XB_SPIN_CAP) { atomicAdd(&bar[XB_TMO], 1u); break; } }
    }
    nloc = mine > 0u ? mine : 1u; nx = cnt > 0u ? cnt : 1u;
}
__device__ __forceinline__ void xcd_barrier(unsigned* bar, volatile LAS unsigned* st) {
    asm volatile("s_waitcnt vmcnt(0)" ::: "memory");
    __syncthreads();
    if (threadIdx.x == 0) {
        __builtin_amdgcn_s_waitcnt(0);
        const unsigned x = xb_xcc_id();
        unsigned nloc = st[0], nx = st[1];
        if (nloc == 0u) { xcd_barrier_complete(bar, x, nloc, nx); st[0] = nloc; st[1] = nx; }
        const unsigned old = xb_add(&bar[XB_XSUB(x)], 1u);
        const unsigned gen = old / nloc;
        if (old + 1u == (gen + 1u) * nloc) {
            __builtin_amdgcn_fence(__ATOMIC_RELEASE, "agent");
            asm volatile("s_waitcnt vmcnt(0)" ::: "memory");
            const unsigned og = xb_add(&bar[XB_TOP], 1u);
            const unsigned tg = og / nx;
            if (og + 1u == (tg + 1u) * nx) xb_add(&bar[XB_TOPGEN], 1u);
            else XB_SPIN(xb_ld(&bar[XB_TOPGEN]) == tg, bar);
            __builtin_amdgcn_fence(__ATOMIC_ACQUIRE, "agent");
            xb_add(&bar[XB_XGEN(x)], 1u);
            asm volatile("s_waitcnt vmcnt(0)" ::: "memory");
        } else {
            XB_SPIN(xb_ld(&bar[XB_XGEN(x)]) == gen, bar);
            __builtin_amdgcn_fence(__ATOMIC_ACQUIRE, "agent");
            asm volatile("s_waitcnt vmcnt(0)" ::: "memory");
        }
    }
    __syncthreads();
}
typedef const __attribute__((address_space(4))) Args* CArgsP;
__device__ __forceinline__ CArgsP largs() { CArgsP p = (CArgsP)__builtin_amdgcn_kernarg_segment_ptr(); asm volatile("" : "+s"(p)); return p; }
__device__ __forceinline__ int otid() { int t = threadIdx.x; asm volatile("" : "+v"(t)); return t; }
__global__ void __launch_bounds__(NTHREADS) mega(Args a) {
    extern __shared__ __attribute__((aligned(16))) unsigned char lds_raw[];
    LAS unsigned char* lds = (LAS unsigned char*)lds_raw;
    cg::grid_group grid = cg::this_grid();
    volatile LAS unsigned* bst = (volatile LAS unsigned*)(lds + 131072);
    if (threadIdx.x < 2) bst[threadIdx.x] = 0u;
    __syncthreads();
    if (gridDim.x == 0x7fffffffu) grid.sync();
    { CArgsP ap0 = largs(); unsigned* bar0 = (unsigned*)ap0->ws; if (threadIdx.x == 0) (void)xb_add(&bar0[XB_XCNT(xb_xcc_id())], 1u); }
#define GSYNC() do { CArgsP apb_ = largs(); xcd_barrier((unsigned*)apb_->ws, bst); } while (0)
    const int G = gridDim.x, bid = blockIdx.x;
    const int NGW = G * NWAVES, NGT = G * NTHREADS;
#define PHASE_IDS() const int tid = otid(), lane = tid & 63, wave = __builtin_amdgcn_readfirstlane(tid >> 6); const int gw = bid * NWAVES + wave; const int gt = bid * NTHREADS + tid; (void)gw; (void)gt; (void)lane; PTRS()
#define PTRS() CArgsP ap_ = largs(); unsigned char* ws = ap_->ws; const float* x_in = (const float*)ap_->in[0]; const float* c_in = (const float*)ap_->in[1]; const int* positions = (const int*)ap_->in[2]; const float* rel_bias = (const float*)ap_->in[3]; const float* w_mod = (const float*)ap_->in[4]; const float* b_mod = (const float*)ap_->in[5]; const float* norm_g = (const float*)ap_->in[6]; const float* a_sink = (const float*)ap_->in[8]; const float* b_conv = (const float*)ap_->in[9]; const float* c_norm_q = (const float*)ap_->in[10]; const float* c_norm_kv = (const float*)ap_->in[11]; const float* ffn_conv = (const float*)ap_->in[16]; float* MOD = (float*)(ws + WS_MOD); float* CS = (float*)(ws + WS_CS); float* LUTA = (float*)(ws + WS_LUT); float* LUTD = LUTA + 4 * 257; bf16_t* HB = (bf16_t*)(ws + WS_HB); bf16_t* PROJ = (bf16_t*)(ws + WS_PROJ); bf16_t* UB = (bf16_t*)(ws + WS_PROJ); bf16_t* ACT = (bf16_t*)(ws + WS_ACT); bf16_t* MIX = (bf16_t*)(ws + WS_MIX); bf16_t* DPART = (bf16_t*)(ws + WS_DPART); bf16_t* KR = (bf16_t*)(ws + WS_KR); float* LSEB = (float*)(ws + WS_LSE); float* xout = ap_->out; (void)ws; (void)x_in; (void)c_in; (void)positions; (void)rel_bias; (void)w_mod; (void)b_mod; (void)norm_g; (void)a_sink; (void)b_conv; (void)c_norm_q; (void)c_norm_kv; (void)ffn_conv; (void)MOD; (void)CS; (void)LUTA; (void)LUTD; (void)HB; (void)PROJ; (void)UB; (void)ACT; (void)MIX; (void)DPART; (void)KR; (void)LSEB; (void)xout

    { PHASE_IDS();
    LAS float* sl = (LAS float*)(lds + 65536);
    for (int i = tid; i < 8 * 1024; i += NTHREADS) { const float cv = c_in[i]; sl[i] = cv * __builtin_amdgcn_rcpf(1.f + __builtin_amdgcn_exp2f(-cv * LOG2E)); }
    __syncthreads();
    for (int it = gw; it < DEPTH * 24 * 16; it += NGW) {
        const int l = it / 384, rem = it % 384, cb = rem >> 4, kc = rem & 15;
        const int col = cb * 256 + 4 * lane;
        const float* w = w_mod + ((size_t)l * 1024 + kc * 64) * 6144 + col;
        f32x4 acc[8];
#pragma unroll
        for (int b = 0; b < 8; ++b) acc[b] = (f32x4){0.f, 0.f, 0.f, 0.f};
        for (int k0 = 0; k0 < 64; k0 += 8) {
            f32x4 wv[8];
#pragma unroll
            for (int k = 0; k < 8; ++k) wv[k] = *(const f32x4*)(w + (size_t)(k0 + k) * 6144);
#pragma unroll
            for (int k = 0; k < 8; ++k)
#pragma unroll
                for (int b = 0; b < 8; ++b) acc[b] += wv[k] * sl[b * 1024 + kc * 64 + k0 + k];
        }
        float* MP = (float*)(ws + WS_ACT);
#pragma unroll
        for (int b = 0; b < 8; ++b) *(f32x4*)(MP + (((size_t)l * 16 + kc) * 8 + b) * 6144 + col) = acc[b];
    }
    __syncthreads();
    convert_weights((const float*)ap_->in[7], (const float*)ap_->in[12], (const float*)ap_->in[13], (const float*)ap_->in[14], (const float*)ap_->in[15], (const float*)ap_->in[17], ws, 0, lds, gw, NGW, wave, lane);
    for (int i = gt; i < T * 16; i += NGT) {
        const int row = i >> 4, j = i & 15;
        const float invf = __builtin_amdgcn_exp2f(-(float)j * (13.287712379549449f / 16.f));
        const float ang = (float)positions[row] * invf;
        const double rev = (double)ang * 0.15915494309189535;
        const float fr = (float)(rev - __builtin_rint(rev));
        CS[(size_t)row * 32 + j] = __builtin_amdgcn_cosf(fr);
        CS[(size_t)row * 32 + 16 + j] = __builtin_amdgcn_sinf(fr);
    }
    if (bid == 0) {
        for (int i = tid; i < 4 * 257; i += NTHREADS) { const int hd = i / 257, rel = i % 257 - 128; LUTA[i] = rel_bias[t5_bucket(rel) * 16 + hd] * LOG2E; }
        for (int i = tid; i < 12 * 129; i += NTHREADS) { const int gh = i / 129, ri = i % 129 - 64, g = gh >> 2, hd = gh & 3; const int d = (g == 0) ? 1 : (g == 1 ? 4 : 16);
            LUTD[i] = rel_bias[t5_bucket(ri * d) * 16 + 4 + 4 * g + hd] * LOG2E; }
    }
    }
    GSYNC();
    { PHASE_IDS(); const float* MP = (const float*)(ws + WS_ACT);
      for (int i = gt; i < DEPTH * 8 * 6144; i += NGT) { const int l = i / (8 * 6144), rem = i % (8 * 6144), b = rem / 6144, col = rem % 6144;
          float s = b_mod[l * 6144 + col];
#pragma unroll
          for (int kc = 0; kc < 16; ++kc) s += MP[(((size_t)l * 16 + kc) * 8 + b) * 6144 + col];
          MOD[i] = s; } }
    GSYNC();
    { PHASE_IDS();
    for (int row = 2 * gw; row < T; row += 2 * NGW) {
        const int b = row >> 12; const float* md = MOD + (size_t)b * 6144;
        row_pass<2>(row, 1, x_in, nullptr, nullptr, nullptr, nullptr, norm_g, md + 1024, md, HB, lane);
    } }
    GSYNC();

    for (int l = 0; l < DEPTH; ++l) {
        { PTRS(); pg8::Gemm g{HB, (const bf16_t*)(ws + W_IN), T, NIN, 1024, 1024}; pg8::StaticOrder S; S.init(T, NIN, G, bid);
          pg8::EpiProj E{PROJ}; pg8::gemm_phase<pg8::EpiProj, true>(lds, g, S, E); }
        GSYNC();
        { PHASE_IDS();
        const f32x4 gq = ((const f32x4*)(c_norm_q + l * 256))[lane];
        const f32x2 gk = ((const f32x2*)(c_norm_kv + l * 128))[lane];
        const float* bw = b_conv + (size_t)l * 3 * 256;
        const f32x4 w0 = ((const f32x4*)bw)[lane], w1 = ((const f32x4*)(bw + 256))[lane], w2 = ((const f32x4*)(bw + 512))[lane];
        for (int row0 = 4 * gw; row0 < T; row0 += 4 * NGW) {
            bf16_t* pr = PROJ + (size_t)row0 * PRM;
            const int s0 = row0 & (SEQ - 1);
            u32x2 cqw[4]; unsigned ckw[4]; u32x2 bbw[4]; u32x2 bcw[6], bhw[6];
#pragma unroll
            for (int q = 0; q < 4; ++q) { cqw[q] = ((const u32x2*)(pr + (size_t)q * PRM + 768))[lane]; ckw[q] = ((const unsigned*)(pr + (size_t)q * PRM + 1024))[lane];
                bbw[q] = ((const u32x2*)(pr + (size_t)q * PRM + 0))[lane]; }
#pragma unroll
            for (int k = 0; k < 6; ++k) { const bool ok = (k == 0) ? (s0 > 0) : ((k == 5) ? (s0 + 4 < SEQ) : true);
                bcw[k] = (u32x2){0u, 0u}; bhw[k] = bcw[k];
                if (ok) { bcw[k] = ((const u32x2*)(pr + (ptrdiff_t)(k - 1) * PRM + 256))[lane]; bhw[k] = ((const u32x2*)(pr + (ptrdiff_t)(k - 1) * PRM + 512))[lane]; } }
            const int rq = lane >> 4, ri = lane & 15;
            const float t1 = bf1(pr[(size_t)rq * PRM + 1152 + ri]), t2 = bf1(pr[(size_t)rq * PRM + 1168 + ri]);
            const float cs_ = CS[(size_t)(row0 + rq) * 32 + ri], sn = CS[(size_t)(row0 + rq) * 32 + 16 + ri];
            f32x4 cqv[4]; float kv0[4], kv1[4], ssq[4], ssk[4];
#pragma unroll
            for (int q = 0; q < 4; ++q) { cqv[q] = unpack4(cqw[q]); kv0[q] = bf_lo(ckw[q]); kv1[q] = bf_hi(ckw[q]);
                ssq[q] = (cqv[q][0] * cqv[q][0] + cqv[q][1] * cqv[q][1]) + (cqv[q][2] * cqv[q][2] + cqv[q][3] * cqv[q][3]); ssk[q] = kv0[q] * kv0[q] + kv1[q] * kv1[q]; }
#pragma unroll
            for (int o = 1; o < 64; o <<= 1) {
#pragma unroll
                for (int q = 0; q < 4; ++q) { ssq[q] += __shfl_xor(ssq[q], o); ssk[q] += __shfl_xor(ssk[q], o); } }
#pragma unroll
            for (int q = 0; q < 4; ++q) {
                const float rq_ = rsqrtf(ssq[q] * (1.f / 256.f) + EPS), rk_ = rsqrtf(ssk[q] * (1.f / 128.f) + EPS);
                ((u32x2*)(pr + (size_t)q * PRM + 768))[lane] = pack4(cqv[q] * rq_ * gq);
                ((unsigned*)(pr + (size_t)q * PRM + 1024))[lane] = pk2(kv0[q] * rk_ * gk[0], kv1[q] * rk_ * gk[1]);
            }
            KR[(size_t)(row0 + rq) * 32 + ri] = (bf16_t)(pk2(t1 * cs_ - t2 * sn, 0.f) & 0xffffu);
            KR[(size_t)(row0 + rq) * 32 + 16 + ri] = (bf16_t)(pk2(t2 * cs_ + t1 * sn, 0.f) & 0xffffu);
            f32x4 prod[6];
#pragma unroll
            for (int k = 0; k < 6; ++k) prod[k] = unpack4(bcw[k]) * unpack4(bhw[k]);
#pragma unroll
            for (int q = 0; q < 4; ++q) { const f32x4 ob = unpack4(bbw[q]) * (prod[q] * w0 + prod[q + 1] * w1 + prod[q + 2] * w2);
                ((u32x2*)(MIX + (size_t)(row0 + q) * 1024 + 256))[lane] = pack4(ob); }
        } }
        { PHASE_IDS();
        if (wave >= 4) __builtin_amdgcn_s_setprio(1);
        for (int ui = 512 + bid; ui < 5 * 512; ui += G) {
            const int kind = ui >> 9, idx = ui & 511;
            const int bb = idx >> 6, rem = idx & 63, head = rem >> 4, rr = rem & 15;
            AU u;
            if (kind == 0) {
                const size_t hrow = (size_t)(bb * 4 + head) * SEQ;
                u.Q = HB + hrow * 96; u.qpitch = 96; u.K1 = HB + (size_t)T * 384 + hrow * 64; u.k1pitch = 64; u.K2 = KR + (size_t)bb * SEQ * 32; u.k2pitch = 32;
                u.V = HB + (size_t)T * 640 + hrow * 64; u.vpitch = 64; u.O = MIX + (size_t)bb * SEQ * 1024 + 512 + head * 64; u.opitch = 1024; u.LSE = nullptr; u.lsepitch = 0; u.lut = nullptr;
                u.R = 1 << 20; u.q0 = 256 * rr; u.kt_lo = 0; u.kt_hi = 64; u.sc = 0.10206207261596575f * LOG2E; u.m0 = -1e30f; u.l0 = 0.f;
                attn_unit_c(lds, u, tid, wave, lane);
            } else {
                int Ls;
                if (kind == 1) {
                    const bf16_t* hmb = PROJ + HM_OFF;
                    u.Q = hmb + ((size_t)(bb * 4 + head) * SEQ) * 64; u.qpitch = 64;
                    u.K1 = hmb + (size_t)T * 256 + ((size_t)(bb * 4 + (head >> 1)) * SEQ) * 64; u.k1pitch = 64;
                    u.V = hmb + (size_t)T * 256 + ((size_t)(bb * 4 + 2 + (head >> 1)) * SEQ) * 64; u.vpitch = 64;
                    u.O = MIX + (size_t)bb * SEQ * 1024 + head * 64; u.opitch = 1024; u.LSE = nullptr; u.lsepitch = 0; u.lut = LUTA + head * 257;
                    u.R = 128; u.q0 = 256 * rr; Ls = SEQ; u.m0 = a_sink[l * 4 + head] * LOG2E; u.l0 = 1.f;
                } else {
                    const int g = kind - 2, d = (g == 0) ? 1 : (g == 1 ? 4 : 16);
                    const int res = rr % d, qb = rr / d; Ls = SEQ / d;
                    const size_t brow = (size_t)bb * SEQ + res;
                    { const bf16_t* hmb = PROJ + HM_OFF; const size_t hoff = ((size_t)(bb * 4 + head) * SEQ + (size_t)res * Ls) * 64;
                      u.Q = hmb + (size_t)(2 + 3 * g) * T * 256 + hoff; u.K1 = hmb + (size_t)(3 + 3 * g) * T * 256 + hoff; u.V = hmb + (size_t)(4 + 3 * g) * T * 256 + hoff;
                      u.qpitch = 64; u.k1pitch = 64; u.vpitch = 64; }
                    u.O = DPART + (size_t)g * T * 256 + brow * 256 + head * 64; u.opitch = d * 256; u.LSE = LSEB + (size_t)g * T * 4 + brow * 4 + head; u.lsepitch = 4 * d;
                    u.lut = LUTD + (g * 4 + head) * 129; u.R = 64; u.q0 = 256 * qb; u.m0 = -1e30f; u.l0 = 0.f;
                }
                u.K2 = nullptr; u.k2pitch = 0; u.sc = 0.125f * LOG2E;
                const int lo = (u.q0 - u.R) >> 6, hi = ((u.q0 + 255 + u.R) >> 6) + 1;
                u.kt_lo = lo < 0 ? 0 : lo; u.kt_hi = hi > (Ls >> 6) ? (Ls >> 6) : hi;
                attn_unit_w(lds, u, tid, wave, lane);
            }
        }
        __builtin_amdgcn_s_setprio(0); }
        GSYNC();
        { PTRS(); pg8::Gemm g{PROJ + 768, (const bf16_t*)(ws + W_MLA), T, 1024, 384, PRM}; pg8::StaticOrder S; S.init(T, 1024, G, bid);
          pg8::EpiMla E{HB, 1024, CS, 0.10206207261596575f * LOG2E}; pg8::gemm_phase<pg8::EpiMla, true>(lds, g, S, E); }
        GSYNC();
        { PHASE_IDS();
        const int hd = lane >> 4;
        for (int row0 = 4 * gw; row0 < T; row0 += 4 * NGW) {
            float lse[4][3]; u32x2 dv[4][3];
#pragma unroll
            for (int q = 0; q < 4; ++q)
#pragma unroll
                for (int g = 0; g < 3; ++g) { lse[q][g] = LSEB[(size_t)g * T * 4 + (size_t)(row0 + q) * 4 + hd]; dv[q][g] = ((const u32x2*)(DPART + (size_t)g * T * 256 + (size_t)(row0 + q) * 256))[lane]; }
#pragma unroll
            for (int q = 0; q < 4; ++q) {
                const float mx = fmaxf(lse[q][0], fmaxf(lse[q][1], lse[q][2]));
                const float e0 = __builtin_amdgcn_exp2f(lse[q][0] - mx), e1 = __builtin_amdgcn_exp2f(lse[q][1] - mx), e2 = __builtin_amdgcn_exp2f(lse[q][2] - mx);
                const float inv = 1.f / (e0 + e1 + e2);
                const f32x4 od = (unpack4(dv[q][0]) * e0 + unpack4(dv[q][1]) * e1 + unpack4(dv[q][2]) * e2) * inv;
                ((u32x2*)(MIX + (size_t)(row0 + q) * 1024 + 768))[lane] = pack4(od);
            }
        } }
        { PHASE_IDS();
        if (wave >= 4) __builtin_amdgcn_s_setprio(1);
        for (int ui = bid; ui < 512; ui += G) {
            const int kind = ui >> 9, idx = ui & 511;
            const int bb = idx >> 6, rem = idx & 63, head = rem >> 4, rr = rem & 15;
            AU u;
            if (kind == 0) {
                const size_t hrow = (size_t)(bb * 4 + head) * SEQ;
                u.Q = HB + hrow * 96; u.qpitch = 96; u.K1 = HB + (size_t)T * 384 + hrow * 64; u.k1pitch = 64; u.K2 = KR + (size_t)bb * SEQ * 32; u.k2pitch = 32;
                u.V = HB + (size_t)T * 640 + hrow * 64; u.vpitch = 64; u.O = MIX + (size_t)bb * SEQ * 1024 + 512 + head * 64; u.opitch = 1024; u.LSE = nullptr; u.lsepitch = 0; u.lut = nullptr;
                u.R = 1 << 20; u.q0 = 256 * rr; u.kt_lo = 0; u.kt_hi = 64; u.sc = 0.10206207261596575f * LOG2E; u.m0 = -1e30f; u.l0 = 0.f;
                attn_unit_c(lds, u, tid, wave, lane);
            } else {
                int Ls;
                if (kind == 1) {
                    const bf16_t* hmb = PROJ + HM_OFF;
                    u.Q = hmb + ((size_t)(bb * 4 + head) * SEQ) * 64; u.qpitch = 64;
                    u.K1 = hmb + (size_t)T * 256 + ((size_t)(bb * 4 + (head >> 1)) * SEQ) * 64; u.k1pitch = 64;
                    u.V = hmb + (size_t)T * 256 + ((size_t)(bb * 4 + 2 + (head >> 1)) * SEQ) * 64; u.vpitch = 64;
                    u.O = MIX + (size_t)bb * SEQ * 1024 + head * 64; u.opitch = 1024; u.LSE = nullptr; u.lsepitch = 0; u.lut = LUTA + head * 257;
                    u.R = 128; u.q0 = 256 * rr; Ls = SEQ; u.m0 = a_sink[l * 4 + head] * LOG2E; u.l0 = 1.f;
                } else {
                    const int g = kind - 2, d = (g == 0) ? 1 : (g == 1 ? 4 : 16);
                    const int res = rr % d, qb = rr / d; Ls = SEQ / d;
                    const size_t brow = (size_t)bb * SEQ + res;
                    { const bf16_t* hmb = PROJ + HM_OFF; const size_t hoff = ((size_t)(bb * 4 + head) * SEQ + (size_t)res * Ls) * 64;
                      u.Q = hmb + (size_t)(2 + 3 * g) * T * 256 + hoff; u.K1 = hmb + (size_t)(3 + 3 * g) * T * 256 + hoff; u.V = hmb + (size_t)(4 + 3 * g) * T * 256 + hoff;
                      u.qpitch = 64; u.k1pitch = 64; u.vpitch = 64; }
                    u.O = DPART + (size_t)g * T * 256 + brow * 256 + head * 64; u.opitch = d * 256; u.LSE = LSEB + (size_t)g * T * 4 + brow * 4 + head; u.lsepitch = 4 * d;
                    u.lut = LUTD + (g * 4 + head) * 129; u.R = 64; u.q0 = 256 * qb; u.m0 = -1e30f; u.l0 = 0.f;
                }
                u.K2 = nullptr; u.k2pitch = 0; u.sc = 0.125f * LOG2E;
                const int lo = (u.q0 - u.R) >> 6, hi = ((u.q0 + 255 + u.R) >> 6) + 1;
                u.kt_lo = lo < 0 ? 0 : lo; u.kt_hi = hi > (Ls >> 6) ? (Ls >> 6) : hi;
                attn_unit_w(lds, u, tid, wave, lane);
            }
        }
        __builtin_amdgcn_s_setprio(0); }
        GSYNC();
        { PTRS(); pg8::Gemm g{MIX, (const bf16_t*)(ws + W_OUT), T, 1024, 1024, 1024}; pg8::StaticOrder S; S.init(T, 1024, G, bid);
          pg8::EpiBf16 E{HB, 1024}; pg8::gemm_phase<pg8::EpiBf16, true>(lds, g, S, E); }
        GSYNC();
        { PHASE_IDS(); const float* MODl = MOD + (size_t)l * 8 * 6144; const float* ng = norm_g + (size_t)l * 4 * 1024;
        for (int row = 4 * gw; row < T; row += 4 * NGW) {
            const int b = row >> 12; const float* md = MODl + (size_t)b * 6144;
            if (l == 0) row_pass<4, false, true>(row, 1, x_in, HB, md + 2048, ng + 1024, (float*)(ws + WS_PROJ + 16 * MiB), ng + 2048, md + 4096, md + 3072, HB, lane);
            else row_pass<4, true, true>(row, 1, (const float*)((const bf16_t*)xout + (size_t)T * DM), HB, md + 2048, ng + 1024, (float*)(ws + WS_PROJ + 16 * MiB), ng + 2048, md + 4096, md + 3072, HB, lane);
        } }
        GSYNC();
        { PTRS(); pg8::Gemm g{HB, (const bf16_t*)(ws + W_UP), T, 2 * DFF, 1024, 1024}; pg8::StaticOrder S; S.init(T, 2 * DFF, G, bid);
          pg8::EpiConv E{ACT, (float*)(ws + WS_PROJ), ffn_conv + (size_t)l * 3 * 5632}; pg8::gemm_phase<pg8::EpiConv, true>(lds, g, S, E); }
        GSYNC();
        { PHASE_IDS();
          pg8::StaticOrder S; S.init(T, 1024, G, bid); pg8::Unit uu;
          const float* UH = (const float*)(ws + WS_PROJ);
          const float* fw = ffn_conv + (size_t)l * 3 * 5632;
          for (int i = 0; S.next(i, uu); ++i) {
              const int pm = uu.pm;
              if (tid < 352) {
                  const int c = 8 * tid, tile = c >> 7, within = c & 127, gcol = 256 * tile + within;
                  float wg[3][8], wv[3][8];
#pragma unroll
                  for (int t3 = 0; t3 < 3; ++t3) { const f32x4 a0 = *(const f32x4*)(fw + t3 * 5632 + c), a1 = *(const f32x4*)(fw + t3 * 5632 + c + 4);
                      const f32x4 b0 = *(const f32x4*)(fw + t3 * 5632 + 2816 + c), b1 = *(const f32x4*)(fw + t3 * 5632 + 2816 + c + 4);
#pragma unroll
                      for (int e = 0; e < 4; ++e) { wg[t3][e] = a0[e]; wg[t3][4 + e] = a1[e]; wv[t3][e] = b0[e]; wv[t3][4 + e] = b1[e]; } }
#pragma unroll
                  for (int which = 0; which < 2; ++which) {
                      const int row = 256 * pm + (which ? 255 : 0), s = row & (SEQ - 1);
                      const float* up_p = which ? UH + ((size_t)pm * 4 + 2) * 5632 : UH + ((size_t)(pm - 1) * 4 + 3) * 5632;
                      const bool up_ok = which ? true : (s != 0);
                      const float* cur_p = UH + ((size_t)pm * 4 + (which ? 3 : 0)) * 5632;
                      const float* dn_p = which ? UH + ((size_t)(pm + 1) * 4) * 5632 : UH + ((size_t)pm * 4 + 1) * 5632;
                      const bool dn_ok = which ? (s != SEQ - 1) : true;
                      float ug[8], uv[8];
#pragma unroll
                      for (int hf = 0; hf < 2; ++hf) {
                          const f32x4 z = {0.f, 0.f, 0.f, 0.f};
                          const f32x4 gu = up_ok ? *(const f32x4*)(up_p + gcol + 4 * hf) : z, vu = up_ok ? *(const f32x4*)(up_p + gcol + 128 + 4 * hf) : z;
                          const f32x4 gc = *(const f32x4*)(cur_p + gcol + 4 * hf), vc = *(const f32x4*)(cur_p + gcol + 128 + 4 * hf);
                          const f32x4 gd = dn_ok ? *(const f32x4*)(dn_p + gcol + 4 * hf) : z, vd = dn_ok ? *(const f32x4*)(dn_p + gcol + 128 + 4 * hf) : z;
#pragma unroll
                          for (int e = 0; e < 4; ++e) { const int k = 4 * hf + e;
                              ug[k] = wg[0][k] * gu[e] + wg[1][k] * gc[e] + wg[2][k] * gd[e];
                              uv[k] = wv[0][k] * vu[e] + wv[1][k] * vc[e] + wv[2][k] * vd[e]; }
                      }
                      u32x4 ow;
#pragma unroll
                      for (int e2 = 0; e2 < 4; ++e2) ow[e2] = pk2(gelu_tanh(ug[2 * e2]) * uv[2 * e2], gelu_tanh(ug[2 * e2 + 1]) * uv[2 * e2 + 1]);
                      *(u32x4*)(ACT + (size_t)row * DFF + c) = ow;
                  }
              }
          }
          asm volatile("s_waitcnt vmcnt(0)" ::: "memory"); __syncthreads();
        }
        { PTRS(); pg8::Gemm g{ACT, (const bf16_t*)(ws + W_DOWN), T, 1024, DFF, DFF}; pg8::StaticOrder S; S.init(T, 1024, G, bid);
          pg8::EpiBf16 E{HB, 1024}; pg8::gemm_phase<pg8::EpiBf16, true>(lds, g, S, E); }
        GSYNC();
        { PHASE_IDS(); const float* MODl = MOD + (size_t)l * 8 * 6144; const float* ng = norm_g + (size_t)l * 4 * 1024;
            const bool lastl = (l == DEPTH - 1);
            const float* MODn = MOD + (size_t)(lastl ? l : l + 1) * 8 * 6144;
            const float* ngn = norm_g + (size_t)(lastl ? l : l + 1) * 4 * 1024;
            for (int row = 4 * gw; row < T; row += 4 * NGW) {
                const int b = row >> 12; const float* md = MODl + (size_t)b * 6144; const float* mdn = MODn + (size_t)b * 6144;
                if (lastl) row_pass<4, true, false>(row, 1, (const float*)(ws + WS_PROJ + 16 * MiB), HB, md + 5120, ng + 3072, xout, ngn, mdn + 1024, mdn, nullptr, lane);
                else row_pass<4, true, true>(row, 1, (const float*)(ws + WS_PROJ + 16 * MiB), HB, md + 5120, ng + 3072, (float*)((bf16_t*)xout + (size_t)T * DM), ngn, mdn + 1024, mdn, HB, lane);
            }
            if (!lastl) convert_weights((const float*)ap_->in[7], (const float*)ap_->in[12], (const float*)ap_->in[13], (const float*)ap_->in[14], (const float*)ap_->in[15], (const float*)ap_->in[17], ws, l + 1, lds, gw, NGW, wave, lane);
        }
        if (l + 1 < DEPTH) GSYNC();
    }
}

extern "C" void kernel_launch(void* const* d_in, const int* in_sizes, int n_in, void* d_out, int out_size, void* d_ws, size_t ws_size, hipStream_t stream) {
    static int grid = 0;
    if (grid == 0) {
        if (n_in != 18 || ws_size < WS_END) { fprintf(stderr, "kernel_launch: unexpected n_in %d / ws_size %zu (need %zu)\n", n_in, ws_size, (size_t)WS_END); grid = -1; return; }
        int dev = 0, cus = 0;
        hipGetDevice(&dev); hipDeviceGetAttribute(&cus, hipDeviceAttributeMultiprocessorCount, dev);
        if (hipFuncSetAttribute((const void*)mega, hipFuncAttributeMaxDynamicSharedMemorySize, LDS_BYTES) != hipSuccess) { fprintf(stderr, "hipFuncSetAttribute failed\n"); grid = -1; return; }
        grid = cus > 0 ? cus : 256;
    }
    if (grid < 0) return;
    hipMemsetAsync(d_ws, 0, XCD_BAR_WORDS * 4, stream);
    Args a{};
    for (int i = 0; i < 18; ++i) a.in[i] = d_in[i];
    a.out = (float*)d_out; a.ws = (unsigned char*)d_ws;
    void* args[] = {&a};
    hipError_t e = hipLaunchCooperativeKernel((const void*)mega, dim3(grid), dim3(NTHREADS), args, LDS_BYTES, stream);
    if (e != hipSuccess) fprintf(stderr, "cooperative launch failed: %s (grid %d)\n", hipGetErrorString(e), grid);
}
```
